# Optimizing an MI355X kernel written in HIP

```python
import math
import jax, jax.numpy as jnp
from jax import lax
import numpy as np

D_MODEL = 1024
BATCH = 16
SEQ = 256
DEPTH = 4
DEC_BATCH = 8
DEC_SEQ = 4096
PAST_LEN = 512

GRID_W = 64
N_MIXERS = 2
N_ATTN_LAYERS = (DEPTH + 1) // 2
N_HYENA_LAYERS = DEPTH // 2
N_HEADS = 8
HEAD_DIM = D_MODEL // N_HEADS // 2
V_DIM = 2 * HEAD_DIM
ROPE_PAIRS = HEAD_DIM // 4
ROPE_BASE = 10000.0
Q_BLOCK = 128
FILT_BANDS = 16
FILT_EMB = 1 + 2 * FILT_BANDS
FILT_ORDER = 64
FILT_TARGET = 1e-2
FILT_FAST_PCT = 0.3
FILT_SLOW_PCT = 1.5
FILT_EPS = 1e-6
D_FF = -(-8 * D_MODEL // (3 * 256)) * 256
EPS = 1e-6
SUBLN_EPS = 1e-5

kernel_name = "diffattn_hyena_hybrid_dit_step"


def rmsnorm(x, g, eps=EPS):
    xf = x.astype(jnp.float32)
    y = xf * lax.rsqrt(jnp.mean(xf * xf, axis=-1, keepdims=True) + eps)
    return (y * g.astype(jnp.float32)).astype(x.dtype)


def adaln(cvec, w, b):
    m = jax.nn.silu(cvec) @ w + b
    return jnp.split(m, 6, axis=-1)


def modulate(h, shift, scale):
    return h * (1.0 + scale) + shift


def swiglu(h, w_gu, w_down):
    g, u = jnp.split(h @ w_gu, 2, axis=-1)
    return (jax.nn.silu(g) * u) @ w_down


def axial_rope(L):
    rows = L // GRID_W
    r, col = jnp.meshgrid(jnp.arange(rows, dtype=jnp.float32), jnp.arange(GRID_W, dtype=jnp.float32), indexing="ij")
    inv = ROPE_BASE ** (-jnp.arange(ROPE_PAIRS, dtype=jnp.float32) / ROPE_PAIRS)
    ang = jnp.stack([r.reshape(-1)[:, None] * inv, col.reshape(-1)[:, None] * inv], axis=1)
    return jnp.cos(ang), jnp.sin(ang)


def apply_rope(x, cos, sin):
    xs = x.reshape(x.shape[:-1] + (2, 2, ROPE_PAIRS))
    x1, x2 = xs[..., 0, :], xs[..., 1, :]
    c = cos[:, None, None].astype(x.dtype)
    s = sin[:, None, None].astype(x.dtype)
    out = jnp.stack([x1 * c - x2 * s, x2 * c + x1 * s], axis=-2)
    return out.reshape(x.shape)


def diff_qkv(h, w_qkv):
    B, L, _ = h.shape
    q, k, v = jnp.split(h @ w_qkv, 3, axis=-1)
    return (q.reshape(B, L, N_HEADS, 2, HEAD_DIM),
            k.reshape(B, L, N_HEADS, 2, HEAD_DIM),
            v.reshape(B, L, N_HEADS, V_DIM))


def diff_lambda(lam_params, layer_idx):
    lp = lam_params.astype(jnp.float32)
    lam_init = 0.8 - 0.6 * math.exp(-0.3 * layer_idx)
    lam = jnp.exp(jnp.sum(lp[0] * lp[1])) - jnp.exp(jnp.sum(lp[2] * lp[3])) + lam_init
    return lam, lam_init


def diff_attend(q, k, v, lam):
    B, Lq = q.shape[:2]
    nblk = Lq // Q_BLOCK
    scale = HEAD_DIM ** -0.5
    qb = q.reshape(B, nblk, Q_BLOCK, N_HEADS, 2, HEAD_DIM).transpose(1, 0, 2, 3, 4, 5)

    def block(qi):
        s = jnp.einsum("bqhpd,bkhpd->bhpqk", qi, k, preferred_element_type=jnp.float32) * scale
        p = jax.nn.softmax(s, axis=-1)
        a = p[:, :, 0] - lam * p[:, :, 1]
        return jnp.einsum("bhqk,bkhe->bqhe", a.astype(v.dtype), v)

    o = lax.map(block, qb)
    return o.transpose(1, 0, 2, 3, 4).reshape(B, Lq, N_HEADS, V_DIM)


def diff_out(o, subln_g, lam_init, w_o):
    o = rmsnorm(o, subln_g, SUBLN_EPS) * (1.0 - lam_init)
    B, L = o.shape[:2]
    return o.reshape(B, L, N_HEADS * V_DIM) @ w_o


def implicit_filter(L, w1, b1, w2, b2, w3, b3, freq):
    f32 = jnp.float32
    pos = jnp.arange(L, dtype=f32)
    t = pos / max(L - 1, 1)
    w = 2.0 * math.pi * pos / L
    bands = jnp.linspace(1e-4, FILT_BANDS - 1, FILT_BANDS, dtype=f32)
    z = jnp.concatenate([t[:, None], jnp.cos(w[:, None] * bands), -jnp.sin(w[:, None] * bands)], axis=-1)
    fr = freq.astype(f32)
    hdn = jnp.sin(fr * (z @ w1.astype(f32) + b1.astype(f32)))
    hdn = jnp.sin(fr * (hdn @ w2.astype(f32) + b2.astype(f32)))
    h = (hdn @ w3.astype(f32) + b3.astype(f32)).reshape(L, 2, D_MODEL)
    deltas = jnp.abs(jnp.linspace(math.log(FILT_TARGET) / FILT_SLOW_PCT,
                                  math.log(FILT_TARGET) / FILT_FAST_PCT, D_MODEL, dtype=f32))
    h = h * jnp.exp(-t[:, None, None] * deltas)
    return h / (jnp.sum(jnp.abs(h), axis=(0, 1), keepdims=True) + FILT_EPS)


def bidir_fftconv(v, filt):
    B, L, D = v.shape
    n = 2 * L
    h_f, h_b = filt[:, 0], filt[:, 1]
    kk = jnp.concatenate([h_f, jnp.zeros((1, D), filt.dtype), h_b[:0:-1]], axis=0)
    vf = jnp.fft.rfft(v.astype(jnp.float32), n=n, axis=1)
    kf = jnp.fft.rfft(kk, n=n, axis=0)
    return jnp.fft.irfft(vf * kf[None], n=n, axis=1)[:, :L]


def hyena(h, w_in, b_in, conv_w, conv_b, fw1, fb1, fw2, fb2, fw3, fb3, freq, skip, w_out, b_out):
    B, L, D = h.shape
    u = h @ w_in + b_in
    up = jnp.pad(u, ((0, 0), (1, 1), (0, 0)))
    u = up[:, :-2] * conv_w[0] + up[:, 1:-1] * conv_w[1] + up[:, 2:] * conv_w[2] + conv_b
    x0, x1, v = jnp.split(u, 3, axis=-1)
    filt = implicit_filter(L, fw1, fb1, fw2, fb2, fw3, fb3, freq)
    v = v * x1
    y = bidir_fftconv(v, filt).astype(h.dtype) + v * skip
    return (y * x0) @ w_out + b_out


def setup_inputs(seed: int = 0) -> dict:
    key = jax.random.key(seed)
    ks = jax.random.split(key, 40)
    f32 = jnp.float32

    def nrm(i, shape, scale=1.0):
        return jax.random.normal(ks[i], shape, f32) * scale

    D = D_MODEL
    NA, NH = N_ATTN_LAYERS, N_HYENA_LAYERS
    return {
        "x_prompt": nrm(0, (BATCH, SEQ, D)),
        "x_sample": nrm(1, (DEC_BATCH, DEC_SEQ, D)),
        "cache_k": nrm(2, (DEC_BATCH, NA, PAST_LEN, N_HEADS, 2, HEAD_DIM)),
        "cache_v": nrm(3, (DEC_BATCH, NA, PAST_LEN, N_HEADS, V_DIM)),
        "c": nrm(4, (DEC_BATCH, D)),
        "c_ctx": nrm(5, (D,)),
        "ada_w": nrm(6, (DEPTH, D, 6 * D), 0.5 * D ** -0.5),
        "ada_b": nrm(7, (DEPTH, 6 * D), 0.01),
        "norm1_g": 1.0 + nrm(8, (DEPTH, D), 0.01),
        "norm2_g": 1.0 + nrm(9, (DEPTH, D), 0.01),
        "attn_w_qkv": nrm(10, (NA, D, 3 * D), D ** -0.5),
        "attn_lambda": nrm(11, (NA, 4, HEAD_DIM), 0.1),
        "attn_subln_g": 1.0 + nrm(12, (NA, V_DIM), 0.01),
        "attn_w_o": nrm(13, (NA, D, D), D ** -0.5),
        "hy_w_in": nrm(14, (NH, D, 3 * D), D ** -0.5),
        "hy_b_in": nrm(15, (NH, 3 * D), 0.01),
        "hy_conv_w": nrm(16, (NH, 3, 3 * D), 3 ** -0.5),
        "hy_conv_b": nrm(17, (NH, 3 * D), 0.01),
        "filt_w1": nrm(18, (NH, FILT_EMB, FILT_ORDER), FILT_EMB ** -0.5),
        "filt_b1": nrm(19, (NH, FILT_ORDER), 0.1),
        "filt_w2": nrm(20, (NH, FILT_ORDER, FILT_ORDER), FILT_ORDER ** -0.5),
        "filt_b2": nrm(21, (NH, FILT_ORDER), 0.1),
        "filt_w3": nrm(22, (NH, FILT_ORDER, 2 * D), FILT_ORDER ** -0.5),
        "filt_b3": nrm(23, (NH, 2 * D), 0.1),
        "filt_freq": 1.0 + nrm(24, (NH, FILT_ORDER), 0.01),
        "hy_skip": nrm(25, (NH, D)),
        "hy_w_out": nrm(26, (NH, D, D), D ** -0.5),
        "hy_b_out": nrm(27, (NH, D), 0.01),
        "ffn_w_gu": nrm(28, (DEPTH, D, 2 * D_FF), D ** -0.5),
        "ffn_w_down": nrm(29, (DEPTH, D_FF, D), D_FF ** -0.5),
        "final_g": 1.0 + nrm(30, (D,), 0.01),
    }


def reference(x_prompt, x_sample, cache_k, cache_v, c, c_ctx, ada_w, ada_b, norm1_g, norm2_g,
              attn_w_qkv, attn_lambda, attn_subln_g, attn_w_o,
              hy_w_in, hy_b_in, hy_conv_w, hy_conv_b, filt_w1, filt_b1, filt_w2, filt_b2,
              filt_w3, filt_b3, filt_freq, hy_skip, hy_w_out, hy_b_out,
              ffn_w_gu, ffn_w_down, final_g):
    def hy_params(j):
        return (hy_w_in[j], hy_b_in[j], hy_conv_w[j], hy_conv_b[j], filt_w1[j], filt_b1[j],
                filt_w2[j], filt_b2[j], filt_w3[j], filt_b3[j], filt_freq[j], hy_skip[j],
                hy_w_out[j], hy_b_out[j])

    xp = x_prompt
    ctx_k, ctx_v = [], []
    for i in range(DEPTH):
        j = i // N_MIXERS
        sh1, sc1, g1, sh2, sc2, g2 = adaln(c_ctx, ada_w[i], ada_b[i])
        h = modulate(rmsnorm(xp, norm1_g[i]), sh1, sc1)
        if i % N_MIXERS == 0:
            lam, lam_init = diff_lambda(attn_lambda[j], i)
            q, k, v = diff_qkv(h, attn_w_qkv[j])
            out = diff_out(diff_attend(q, k, v, lam), attn_subln_g[j], lam_init, attn_w_o[j])
            ctx_k.append(k)
            ctx_v.append(v)
        else:
            out = hyena(h, *hy_params(j))
        xp = xp + g1 * out
        h = modulate(rmsnorm(xp, norm2_g[i]), sh2, sc2)
        xp = xp + g2 * swiglu(h, ffn_w_gu[i], ffn_w_down[i])
    y_prompt = rmsnorm(xp, final_g)
    new_cache_k = jnp.stack(ctx_k, axis=1)
    new_cache_v = jnp.stack(ctx_v, axis=1)

    xs = x_sample
    cos, sin = axial_rope(xs.shape[1])
    cmod = c[:, None, :]
    for i in range(DEPTH):
        j = i // N_MIXERS
        sh1, sc1, g1, sh2, sc2, g2 = adaln(cmod, ada_w[i], ada_b[i])
        h = modulate(rmsnorm(xs, norm1_g[i]), sh1, sc1)
        if i % N_MIXERS == 0:
            lam, lam_init = diff_lambda(attn_lambda[j], i)
            q, k, v = diff_qkv(h, attn_w_qkv[j])
            q = apply_rope(q, cos, sin)
            k = apply_rope(k, cos, sin)
            k_all = jnp.concatenate([cache_k[:, j].astype(k.dtype), k], axis=1)
            v_all = jnp.concatenate([cache_v[:, j].astype(v.dtype), v], axis=1)
            out = diff_out(diff_attend(q, k_all, v_all, lam), attn_subln_g[j], lam_init, attn_w_o[j])
        else:
            out = hyena(h, *hy_params(j))
        xs = xs + g1 * out
        h = modulate(rmsnorm(xs, norm2_g[i]), sh2, sc2)
        xs = xs + g2 * swiglu(h, ffn_w_gu[i], ffn_w_down[i])
    y_sample = rmsnorm(xs, final_g)

    return (y_prompt, y_sample, new_cache_k, new_cache_v)
```

```cpp
#include <hip/hip_runtime.h>
#include <hip/hip_bf16.h>
#include <hip/hip_cooperative_groups.h>
#include <cstdio>
#include <cstdint>
namespace cg = cooperative_groups;
__device__ __forceinline__ int tidx() { int t = threadIdx.x; asm volatile("" : "+v"(t)); return t; }

namespace pg8 {
#define PG8_LAS __attribute__((address_space(3)))
typedef unsigned short bf16_t;
typedef short bf16x8 __attribute__((ext_vector_type(8)));
typedef float f32x4 __attribute__((ext_vector_type(4)));
typedef unsigned u32x4 __attribute__((ext_vector_type(4)));
constexpr int BM = 256, BK = 64, HALF = 128, HTB = HALF * BK * 2  , STAGE_BYTES = 8 * HTB, NXCD = 8, WGM = 8;

__host__ __device__ __forceinline__ int lds_byte(int r, int c) { const int st = (r >> 4) * 2 + (c >> 5), rr = r & 15, cc = c & 31, ob = rr * 64 + cc * 2; return st * 1024 + (ob ^ (((ob >> 9) & 1) << 5)); }
__host__ __device__ __forceinline__ void stage_rc(int b, int& R, int& C) { const int st = b / 1024, sb = b % 1024, swz = sb ^ (((sb >> 9) & 1) << 5); R = (st >> 1) * 16 + swz / 64; C = (st & 1) * 32 + (swz % 64) / 2; }
__host__ __device__ __forceinline__ int perm32(int rho) { const int n = rho >> 4, i = rho & 15; return 8 * (i >> 2) + 4 * n + (i & 3); }

struct Unit { int pm, pn, kt0, nkt, split; };
struct Gemm { const bf16_t* A; const bf16_t* Bt; int M, N, K; };

struct StaticOrder {
    int nM, nN, nwg, G, c;
    __host__ __device__ void init(int M, int N, int G_, int c_) { nM = M / BM; nN = N / BM; nwg = nM * nN; G = G_; c = c_; }
    __host__ __device__ bool next(int i, Unit& u) const {
        const long L = (long)i * G + c; if (L >= nwg) return false;
        int wgid = (int)L; { const int q = nwg / NXCD, r = nwg % NXCD, xcd = wgid % NXCD, off = wgid / NXCD; wgid = (xcd < r ? xcd * (q + 1) : r * (q + 1) + (xcd - r) * q) + off; }
        const int nig = WGM * nN, gid = wgid / nig, fm = gid * WGM, gsz = (nM - fm) < WGM ? (nM - fm) : WGM;
        u.pm = fm + ((wgid % nig) % gsz); u.pn = (wgid % nig) / gsz; u.kt0 = 0; u.nkt = 0; u.split = -1; return true;
    }
    __device__ __forceinline__ void a_ready(const Unit&) const {}
    __device__ __forceinline__ void done(const Unit&) const {}
};

__device__ __forceinline__ unsigned cvt_pk_bf16(float lo, float hi) { unsigned r; asm volatile("v_cvt_pk_bf16_f32 %0, %1, %2" : "=v"(r) : "v"(lo), "v"(hi)); return r; }

struct SplitOrder {
    int G, c, nt;
    __host__ __device__ void init(int K, int G_, int c_) { nt = K / BK; G = G_; c = c_; }
    __host__ __device__ bool next(int i, Unit& u) const {
        const int L = i * G + c; if (L >= 512 + 256) return false;
        int tile;
        if (L < 512) { tile = (L % NXCD) * 64 + L / NXCD; u.kt0 = 0; u.nkt = 0; u.split = -1; }
        else { const int r = L - 512, s = r & 3; tile = 512 + (r >> 2);
            const int q = (nt / 4) & ~1, rp = (nt - 4 * q) / 2;
            u.split = s; u.nkt = q + (s < rp ? 2 : 0); u.kt0 = s * q + 2 * (s < rp ? s : rp); }
        const int gid = tile >> 5, w = tile & 31;
        u.pm = gid * 8 + (w & 7); u.pn = w >> 3; return true;
    }
    __device__ __forceinline__ void a_ready(const Unit&) const {}
    __device__ __forceinline__ void done(const Unit&) const {}
};
typedef unsigned u32x2 __attribute__((ext_vector_type(2)));
struct EpiBf16 {
    static constexpr bool PERM = true, AFTER_DRAIN = false;
    bf16_t* O; int ldc; const float* bias;
    __device__ __forceinline__ void operator()(const f32x4 (&acc)[2][2][4][2], const Unit& u, int wr, int wc, int fr, int fq) const {
        const int row0 = u.pm * BM + wr * 64 + fr; const int col0 = u.pn * BM + wc * 32 + 8 * fq;
        f32x4 bv[2][2];
#pragma unroll
        for (int bj = 0; bj < 2; ++bj)
#pragma unroll
            for (int n = 0; n < 2; ++n) bv[bj][n] = *(const f32x4*)(bias + col0 + bj * HALF + 4 * n);
#pragma unroll
        for (int ai = 0; ai < 2; ++ai)
#pragma unroll
            for (int m = 0; m < 4; ++m) { bf16_t* rowp = O + (size_t)(row0 + ai * HALF + m * 16) * ldc + col0;
#pragma unroll
                for (int bj = 0; bj < 2; ++bj) { const f32x4 v0 = acc[ai][bj][m][0] + bv[bj][0], v1 = acc[ai][bj][m][1] + bv[bj][1];
                    u32x4 w; w.x = cvt_pk_bf16(v0[0], v0[1]); w.y = cvt_pk_bf16(v0[2], v0[3]); w.z = cvt_pk_bf16(v1[0], v1[1]); w.w = cvt_pk_bf16(v1[2], v1[3]);
                    *(u32x4*)(rowp + bj * HALF) = w; } }
    }
};
__device__ __forceinline__ float silu_f(float x) { return x * __builtin_amdgcn_rcpf(1.0f + __builtin_amdgcn_exp2f(-1.4426950408889634f * x)); }
struct EpiSwiglu {
    static constexpr bool PERM = true, AFTER_DRAIN = false;
    bf16_t* O;
    __device__ __forceinline__ void operator()(const f32x4 (&acc)[2][2][4][2], const Unit& u, int wr, int wc, int fr, int fq) const {
        const int row0 = u.pm * BM + wr * 64 + fr; const int col0 = u.pn * HALF + wc * 32 + 8 * fq;
#pragma unroll
        for (int ai = 0; ai < 2; ++ai)
#pragma unroll
            for (int m = 0; m < 4; ++m) { bf16_t* rowp = O + (size_t)(row0 + ai * HALF + m * 16) * 2816 + col0;
                const f32x4 g0 = acc[ai][0][m][0], g1 = acc[ai][0][m][1], u0 = acc[ai][1][m][0], u1 = acc[ai][1][m][1];
                float r[8];
#pragma unroll
                for (int i = 0; i < 4; ++i) { r[i] = silu_f(g0[i]) * u0[i]; r[4 + i] = silu_f(g1[i]) * u1[i]; }
                u32x4 w; w.x = cvt_pk_bf16(r[0], r[1]); w.y = cvt_pk_bf16(r[2], r[3]); w.z = cvt_pk_bf16(r[4], r[5]); w.w = cvt_pk_bf16(r[6], r[7]);
                *(u32x4*)rowp = w; }
    }
};
struct EpiRes {
    static constexpr bool PERM = true, AFTER_DRAIN = false;
    bf16_t* X16; const float* xs_ctx; const float* xs_smp; const float* gate; const float* bias; int first;
    __device__ __forceinline__ void operator()(const f32x4 (&acc)[2][2][4][2], const Unit& u, int wr, int wc, int fr, int fq) const {
        const int g = u.pm >> 4; const float* gp = gate + (size_t)g * 6144;
        const int col0 = u.pn * BM + wc * 32 + 8 * fq;
#pragma unroll
        for (int bj = 0; bj < 2; ++bj) {
            const int co = col0 + bj * HALF;
            const f32x4 gv0 = *(const f32x4*)(gp + co), gv1 = *(const f32x4*)(gp + co + 4);
            const f32x4 bv0 = bias ? *(const f32x4*)(bias + co) : (f32x4){0.f, 0.f, 0.f, 0.f}, bv1 = bias ? *(const f32x4*)(bias + co + 4) : (f32x4){0.f, 0.f, 0.f, 0.f};
#pragma unroll
            for (int ai = 0; ai < 2; ++ai)
#pragma unroll
                for (int m = 0; m < 4; ++m) { const int row = u.pm * BM + ai * HALF + wr * 64 + m * 16 + fr;
                    bf16_t* xo = X16 + (size_t)row * 1024 + co;
                    f32x4 o0, o1;
                    if (first) { const float* xs = (g == 0 ? xs_ctx + (size_t)row * 1024 : xs_smp + (size_t)(row - 4096) * 1024) + co; o0 = __builtin_nontemporal_load((const f32x4*)xs); o1 = __builtin_nontemporal_load((const f32x4*)(xs + 4)); }
                    else { const u32x4 w = __builtin_nontemporal_load((const u32x4*)xo); o0 = (f32x4){__builtin_bit_cast(float, w.x << 16), __builtin_bit_cast(float, w.x & 0xffff0000u), __builtin_bit_cast(float, w.y << 16), __builtin_bit_cast(float, w.y & 0xffff0000u)};
                        o1 = (f32x4){__builtin_bit_cast(float, w.z << 16), __builtin_bit_cast(float, w.z & 0xffff0000u), __builtin_bit_cast(float, w.w << 16), __builtin_bit_cast(float, w.w & 0xffff0000u)}; }
                    const f32x4 n0 = o0 + gv0 * (acc[ai][bj][m][0] + bv0), n1 = o1 + gv1 * (acc[ai][bj][m][1] + bv1);
                    u32x4 wn; wn.x = cvt_pk_bf16(n0[0], n0[1]); wn.y = cvt_pk_bf16(n0[2], n0[3]); wn.z = cvt_pk_bf16(n1[0], n1[1]); wn.w = cvt_pk_bf16(n1[2], n1[3]);
                    *(u32x4*)xo = wn; }
        }
    }
};
constexpr float QSCALE = 0.125f * 1.4426950408889634f;
struct EpiQKV {
    static constexpr bool PERM = false, AFTER_DRAIN = false;
    unsigned char* qbase; float* ck; const float* rcos; const float* rsin;
    __device__ __forceinline__ void operator()(const f32x4 (&acc)[2][2][4][2], const Unit& u, int wr, int wc, int fr, int fq) const {
        const int part = u.pn >> 2, colt = (u.pn & 3) * BM, g = u.pm >> 4;
        const int col0 = colt + wc * 32 + 4 * fq;
        const bool rope = (g > 0) && (part < 2);
        const int axis = wc & 1;
        bf16_t* const dstb = (bf16_t*)(qbase + (size_t)part * (72u << 20) + (size_t)(part >> 1) * (8u << 20));
        float* const cdst = ck + (size_t)(part >> 1) * ((size_t)16 * 2 * 256 * 1024);
#pragma unroll
        for (int ai = 0; ai < 2; ++ai)
#pragma unroll
            for (int m = 0; m < 4; ++m) {
                const int row = u.pm * BM + ai * HALF + wr * 64 + m * 16 + fr;
                const int t = row & 4095;
                f32x4 c4 = (f32x4){1.f, 1.f, 1.f, 1.f}, s4 = (f32x4){0.f, 0.f, 0.f, 0.f};
                if (rope) { const int posi = axis ? (t & 63) : (t >> 6); c4 = *(const f32x4*)(rcos + posi * 16 + 4 * fq); s4 = *(const f32x4*)(rsin + posi * 16 + 4 * fq); }
                size_t drow = (size_t)row;
                if (part != 0 && g > 0) drow = (size_t)(4096 + (g - 1) * 4608 + 512 + t);
                bf16_t* base = dstb + drow * 1024 + col0;
#pragma unroll
                for (int bj = 0; bj < 2; ++bj) {
                    const f32x4 v0 = acc[ai][bj][m][0], v1 = acc[ai][bj][m][1];
                    const bool odd = fq & 1; const int cofs = bj * HALF + (odd ? 12 : 0);
                    if (g == 0 && part != 0) { float* o = cdst + (size_t)(row >> 8) * (2 * 256 * 1024) + (size_t)(row & 255) * 1024 + col0 + cofs;
                        const f32x4 snd = odd ? v0 : v1; f32x4 rcv; rcv[0] = __shfl_xor(snd[0], 16); rcv[1] = __shfl_xor(snd[1], 16); rcv[2] = __shfl_xor(snd[2], 16); rcv[3] = __shfl_xor(snd[3], 16);
                        __builtin_nontemporal_store(odd ? rcv : v0, (f32x4*)o); __builtin_nontemporal_store(odd ? v1 : rcv, (f32x4*)(o + 4)); }
                    f32x4 o0 = v0 * c4 - v1 * s4, o1 = v1 * c4 + v0 * s4;
                    if (part == 0) { o0 = o0 * QSCALE; o1 = o1 * QSCALE; }
                    u32x2 w0, w1; w0.x = cvt_pk_bf16(o0[0], o0[1]); w0.y = cvt_pk_bf16(o0[2], o0[3]); w1.x = cvt_pk_bf16(o1[0], o1[1]); w1.y = cvt_pk_bf16(o1[2], o1[3]);
                    const u32x2 snd = odd ? w0 : w1; u32x2 rcv; rcv.x = __shfl_xor(snd.x, 16); rcv.y = __shfl_xor(snd.y, 16);
                    u32x4 wo; if (odd) { wo.x = rcv.x; wo.y = rcv.y; wo.z = w1.x; wo.w = w1.y; } else { wo.x = w0.x; wo.y = w0.y; wo.z = rcv.x; wo.w = rcv.y; }
                    *(u32x4*)(base + cofs) = wo; }
            }
    }
};

template <class Epi, class Sched, bool ALIGN_EPI = false, bool SP2 = false>
__device__ __forceinline__ void gemm_phase(PG8_LAS unsigned char* lds, const Gemm g, const Sched& S, const Epi& E) {
    const int tid = tidx(), wid = __builtin_amdgcn_readfirstlane(tid >> 6), lane = tid & 63, wr = wid >> 2, wc = wid & 3, fr = lane & 15, fq = lane >> 4;
    const int K = g.K, nt = K / BK;
    unsigned voffA[2], voffB[2];
#pragma unroll
    for (int i = 0; i < 2; ++i) { int R, C; stage_rc(tid * 16 + i * 8192, R, C); const int Rb = Epi::PERM ? ((R & ~31) + perm32(R & 31)) : R;
        voffA[i] = (unsigned)(R * K + C) * 2u; voffB[i] = (unsigned)(Rb * K + C) * 2u; }
    const size_t kstep = (size_t)(BK * 2);
    const size_t hstep = (size_t)HALF * K * 2;
    const size_t tstep = 2 * hstep;
    const unsigned ldsw = (unsigned)wid * 1024u;
    const int aoff = lds_byte(wr * 64 + fr, fq * 8), boff = lds_byte(wc * 32 + fr, fq * 8);
#define PG8_SA(b, h) (((b) * 2 + (h)) * HTB)
#define PG8_SB(b, h) ((4 + (b) * 2 + (h)) * HTB)
#define PG8_STAGE(bufoff, gbase, voff) do { _Pragma("unroll") for (int _i = 0; _i < 2; ++_i) \
        __builtin_amdgcn_global_load_lds((const unsigned*)((const char*)(gbase) + (voff)[_i]), (PG8_LAS unsigned*)(lds + (bufoff) + ldsw + _i * 8192), 16, 0, 0); } while (0)
#define PG8_LDA(dst, b, h) do { _Pragma("unroll") for (int m = 0; m < 4; ++m) _Pragma("unroll") for (int k = 0; k < 2; ++k) dst[m][k] = *(const PG8_LAS bf16x8*)(lds + PG8_SA(b, h) + aoff + m * 2048 + k * 1024); } while (0)
#define PG8_LDB(dst, b, h) do { _Pragma("unroll") for (int n = 0; n < 2; ++n) _Pragma("unroll") for (int k = 0; k < 2; ++k) dst[n][k] = *(const PG8_LAS bf16x8*)(lds + PG8_SB(b, h) + boff + n * 2048 + k * 1024); } while (0)
#define PG8_MMA(ai, bj, At, Bt) do { __builtin_amdgcn_s_setprio(1); _Pragma("unroll") for (int m = 0; m < 4; ++m) _Pragma("unroll") for (int n = 0; n < 2; ++n) _Pragma("unroll") for (int k = 0; k < 2; ++k) \
        acc[ai][bj][m][n] = __builtin_amdgcn_mfma_f32_16x16x32_bf16(Bt[n][k], At[m][k], acc[ai][bj][m][n], 0, 0, 0); __builtin_amdgcn_s_setprio(0); } while (0)
#define PG8_WAIT_V(n) asm volatile("s_waitcnt vmcnt(" #n ")" ::: "memory")
#define PG8_WAIT_L(n) asm volatile("s_waitcnt lgkmcnt(" #n ")" ::: "memory")
#define PG8_BAR __builtin_amdgcn_s_barrier()
#define PG8_SCHED __builtin_amdgcn_sched_barrier(0)
    Unit cur, nxt; int ui = 0;
    if (!S.next(0, cur)) return;
    f32x4 acc[2][2][4][2];
#pragma unroll
    for (int a = 0; a < 2; ++a)
#pragma unroll
        for (int b = 0; b < 2; ++b)
#pragma unroll
            for (int m = 0; m < 4; ++m)
#pragma unroll
                for (int n = 0; n < 2; ++n) acc[a][b][m][n] = (f32x4){0.f, 0.f, 0.f, 0.f};
    bf16x8 At[4][2], B0[2][2], B1[2][2];
    const char* cA = (const char*)g.A + (size_t)cur.pm * tstep + (size_t)cur.kt0 * kstep; const char* cB = (const char*)g.Bt + (size_t)cur.pn * tstep + (size_t)cur.kt0 * kstep;
    S.a_ready(cur);
    if constexpr (SP2) {
        PG8_STAGE(PG8_SB(0, 0), cB, voffB); PG8_STAGE(PG8_SB(0, 1), cB + hstep, voffB); PG8_STAGE(PG8_SA(0, 0), cA, voffA); PG8_STAGE(PG8_SA(0, 1), cA + hstep, voffA);
        if (wr == 1) PG8_BAR;
        PG8_WAIT_V(2); PG8_BAR;
        PG8_STAGE(PG8_SB(1, 0), cB + kstep, voffB); PG8_STAGE(PG8_SA(1, 0), cA + kstep, voffA); PG8_STAGE(PG8_SB(1, 1), cB + hstep + kstep, voffB);
        PG8_WAIT_V(6); PG8_BAR;
    } else {
        PG8_STAGE(PG8_SB(0, 0), cB, voffB); PG8_STAGE(PG8_SA(0, 0), cA, voffA); PG8_STAGE(PG8_SB(0, 1), cB + hstep, voffB); PG8_STAGE(PG8_SA(0, 1), cA + hstep, voffA);
        if (wr == 1) PG8_BAR;
        PG8_WAIT_V(4); PG8_BAR;
        PG8_STAGE(PG8_SB(1, 0), cB + kstep, voffB); PG8_STAGE(PG8_SA(1, 0), cA + kstep, voffA); PG8_STAGE(PG8_SB(1, 1), cB + hstep + kstep, voffB);
        PG8_WAIT_V(6); PG8_BAR;
    }
    for (;;) {
        const bool has_next = S.next(ui + 1, nxt);
        const char* nA = has_next ? (const char*)g.A + (size_t)nxt.pm * tstep + (size_t)nxt.kt0 * kstep : cA; const char* nB = has_next ? (const char*)g.Bt + (size_t)nxt.pn * tstep + (size_t)nxt.kt0 * kstep : cB;
        const int unt = cur.nkt ? cur.nkt : nt;
        for (int t = 0; t < unt; t += 2) {
            const bool last = (t == unt - 2);
            const char* a1 = cA + (size_t)(t + 1) * kstep;
            const char* a2 = last ? nA : cA + (size_t)(t + 2) * kstep; const char* b2 = last ? nB : cB + (size_t)(t + 2) * kstep;
            const char* a3 = a2 + kstep; const char* b3 = b2 + kstep;
            if (last && has_next) S.a_ready(nxt);
            if constexpr (SP2) {
            PG8_LDB(B0, 0, 0); PG8_LDB(B1, 0, 1); PG8_SCHED; PG8_LDA(At, 0, 0); PG8_STAGE(PG8_SA(1, 1), a1 + hstep, voffA);
            PG8_WAIT_V(8); PG8_WAIT_L(0); PG8_BAR; PG8_MMA(0, 0, At, B0); PG8_MMA(0, 1, At, B1); PG8_BAR; PG8_SCHED;
            PG8_LDA(At, 0, 1); PG8_STAGE(PG8_SB(0, 0), b2, voffB); PG8_STAGE(PG8_SB(0, 1), b2 + hstep, voffB); PG8_STAGE(PG8_SA(0, 0), a2, voffA);
            PG8_WAIT_V(8); PG8_WAIT_L(0); PG8_BAR; PG8_MMA(1, 0, At, B0); PG8_MMA(1, 1, At, B1); PG8_BAR; PG8_SCHED;
            PG8_LDB(B0, 1, 0); PG8_LDB(B1, 1, 1); PG8_SCHED; PG8_LDA(At, 1, 0); PG8_STAGE(PG8_SA(0, 1), a2 + hstep, voffA);
            PG8_WAIT_V(8); PG8_WAIT_L(0); PG8_BAR; PG8_MMA(0, 0, At, B0); PG8_MMA(0, 1, At, B1); PG8_BAR; PG8_SCHED;
            PG8_LDA(At, 1, 1); PG8_STAGE(PG8_SB(1, 0), b3, voffB); PG8_STAGE(PG8_SB(1, 1), b3 + hstep, voffB); PG8_STAGE(PG8_SA(1, 0), a3, voffA);
            PG8_WAIT_V(8); PG8_WAIT_L(0); PG8_BAR; PG8_MMA(1, 0, At, B0); PG8_MMA(1, 1, At, B1); PG8_BAR; PG8_SCHED;
            } else {
            PG8_LDB(B0, 0, 0); PG8_SCHED; PG8_LDA(At, 0, 0); PG8_STAGE(PG8_SA(1, 1), a1 + hstep, voffA);
            PG8_WAIT_L(8); PG8_BAR; PG8_WAIT_L(0); PG8_MMA(0, 0, At, B0); PG8_BAR; PG8_SCHED;
            PG8_LDB(B1, 0, 1); PG8_STAGE(PG8_SB(0, 0), b2, voffB);
            PG8_BAR; PG8_WAIT_L(0); PG8_MMA(0, 1, At, B1); PG8_BAR;
            PG8_LDA(At, 0, 1); PG8_STAGE(PG8_SA(0, 0), a2, voffA);
            PG8_BAR; PG8_WAIT_L(0); PG8_MMA(1, 0, At, B0); PG8_BAR; PG8_SCHED;
            PG8_STAGE(PG8_SB(0, 1), b2 + hstep, voffB);
            PG8_WAIT_V(6); PG8_BAR; PG8_MMA(1, 1, At, B1); PG8_BAR;
            PG8_LDB(B0, 1, 0); PG8_SCHED; PG8_LDA(At, 1, 0); PG8_STAGE(PG8_SA(0, 1), a2 + hstep, voffA);
            PG8_WAIT_L(8); PG8_BAR; PG8_WAIT_L(0); PG8_MMA(0, 0, At, B0); PG8_BAR; PG8_SCHED;
            PG8_LDB(B1, 1, 1); PG8_STAGE(PG8_SB(1, 0), b3, voffB);
            PG8_BAR; PG8_WAIT_L(0); PG8_MMA(0, 1, At, B1); PG8_BAR;
            PG8_LDA(At, 1, 1); PG8_STAGE(PG8_SA(1, 0), a3, voffA);
            PG8_BAR; PG8_WAIT_L(0); PG8_MMA(1, 0, At, B0); PG8_BAR; PG8_SCHED;
            PG8_STAGE(PG8_SB(1, 1), b3 + hstep, voffB);
            PG8_WAIT_V(6); PG8_BAR; PG8_MMA(1, 1, At, B1); PG8_BAR;
            }
        }
        if constexpr (ALIGN_EPI) { if (wr == 0) PG8_BAR; }
        if constexpr (!Epi::AFTER_DRAIN) { E(acc, cur, wr, wc, fr, fq); S.done(cur); }
        if (!has_next) break;
#pragma unroll
        for (int a = 0; a < 2; ++a)
#pragma unroll
            for (int b = 0; b < 2; ++b)
#pragma unroll
                for (int m = 0; m < 4; ++m)
#pragma unroll
                    for (int n = 0; n < 2; ++n) acc[a][b][m][n] = (f32x4){0.f, 0.f, 0.f, 0.f};
        cur = nxt; cA = nA; cB = nB; ++ui;
        if constexpr (ALIGN_EPI) { if (wr == 1) PG8_BAR; }
    }
    PG8_WAIT_V(0);
    if constexpr (!ALIGN_EPI) { if (wr == 0) PG8_BAR; }
    PG8_BAR;
    if constexpr (Epi::AFTER_DRAIN) { E.fused(acc, cur, wr, wc, fr, fq, lds, wid, lane); S.done(cur); }
#undef PG8_SA
#undef PG8_SB
#undef PG8_STAGE
#undef PG8_LDA
#undef PG8_LDB
#undef PG8_MMA
#undef PG8_WAIT_V
#undef PG8_WAIT_L
#undef PG8_BAR
#undef PG8_SCHED
}
}
namespace attn {
using bf16 = __hip_bfloat16;
constexpr int NW = 8, QBLK = 32, KVBLK = 64, LD = 1024;
constexpr float SCALE = 0.125f;
constexpr float THR = 8.f;
constexpr size_t SHM_V = KVBLK * 128 * 2, SHM_K = KVBLK * 128 * 2, SHM_ATTN = 2 * SHM_V + 2 * SHM_K + NW * 64 * 4;
using bf16x8 = __attribute__((ext_vector_type(8))) short;
using s16x4  = __attribute__((ext_vector_type(4))) short;
using f32x16 = __attribute__((ext_vector_type(16))) float;
using u32x4  = __attribute__((ext_vector_type(4))) unsigned;
#define KSWZ(row, colB) ((row) * 256 + ((colB) ^ (((row) & 7) << 4)))
#define SBAR() __builtin_amdgcn_sched_barrier(0)
__device__ __forceinline__ int crow(int r, int hi) { return (r & 3) + 8 * (r >> 2) + 4 * hi; }
__device__ __forceinline__ unsigned cvtpk(float lo, float hi) { unsigned r; asm volatile("v_cvt_pk_bf16_f32 %0, %1, %2" : "=v"(r) : "v"(lo), "v"(hi)); return r; }
__device__ __forceinline__ bf16x8 ld8(const bf16* p) { return *reinterpret_cast<const bf16x8*>(p); }

constexpr float THRL = THR * 1.4426950408889634f;
template <bool FIRST> __device__ __forceinline__ void partialSM(f32x16& p0, f32x16& p1, float& m_reg, float& alpha) {
  float pmax = fmaxf(fmaxf(p0[0], p0[1]), p1[0]);
#pragma unroll
  for (int r = 2; r < 16; r += 2) pmax = fmaxf(fmaxf(pmax, p0[r]), p0[r + 1]);
#pragma unroll
  for (int r = 1; r < 15; r += 2) pmax = fmaxf(fmaxf(pmax, p1[r]), p1[r + 1]);
  pmax = fmaxf(pmax, p1[15]);
  { auto rr = __builtin_amdgcn_permlane32_swap(__float_as_uint(pmax), __float_as_uint(pmax), false, false);
    pmax = fmaxf(__uint_as_float(rr[0]), __uint_as_float(rr[1])); }
  alpha = 1.f;
  if (FIRST || !__builtin_expect(__all(pmax <= THRL), 1)) {
    const float dl = FIRST ? pmax : fmaxf(pmax, 0.f);
    m_reg += dl; if (!FIRST) alpha = __builtin_amdgcn_exp2f(-dl);
#pragma unroll
    for (int r = 0; r < 16; ++r) { p0[r] -= dl; p1[r] -= dl; }
  }
#pragma unroll
  for (int r = 0; r < 16; ++r) p0[r] = __builtin_amdgcn_exp2f(p0[r]);
}
__device__ __forceinline__ void finishSM(f32x16& p0, f32x16& p1, float alpha, float& l_reg, bf16x8& pa0, bf16x8& pa1, bf16x8& pa2, bf16x8& pa3) {
#pragma unroll
  for (int r = 0; r < 16; ++r) p1[r] = __builtin_amdgcn_exp2f(p1[r]);
  float ps;
  { const f32x16 t = p0 + p1; typedef float f32x8v __attribute__((ext_vector_type(8))); typedef float f32x4v __attribute__((ext_vector_type(4))); typedef float f32x2v __attribute__((ext_vector_type(2)));
    const f32x8v t8 = __builtin_shufflevector(t, t, 0, 1, 2, 3, 4, 5, 6, 7) + __builtin_shufflevector(t, t, 8, 9, 10, 11, 12, 13, 14, 15);
    const f32x4v t4 = __builtin_shufflevector(t8, t8, 0, 1, 2, 3) + __builtin_shufflevector(t8, t8, 4, 5, 6, 7);
    const f32x2v t2 = __builtin_shufflevector(t4, t4, 0, 1) + __builtin_shufflevector(t4, t4, 2, 3); ps = t2.x + t2.y; }
  { auto rr = __builtin_amdgcn_permlane32_swap(__float_as_uint(ps), __float_as_uint(ps), false, false);
    ps = __uint_as_float(rr[0]) + __uint_as_float(rr[1]); }
  l_reg = l_reg * alpha + ps;
#define PK4(P, BASE, OUT) do { unsigned a0 = cvtpk(P[BASE + 0], P[BASE + 1]), a1 = cvtpk(P[BASE + 2], P[BASE + 3]);   \
    unsigned b0 = cvtpk(P[BASE + 4], P[BASE + 5]), b1 = cvtpk(P[BASE + 6], P[BASE + 7]);                              \
    auto r0 = __builtin_amdgcn_permlane32_swap(a0, b0, false, false); auto r1 = __builtin_amdgcn_permlane32_swap(a1, b1, false, false); \
    u32x4 w = {r0[0], r1[0], r0[1], r1[1]}; OUT = *reinterpret_cast<bf16x8*>(&w); } while (0)
  PK4(p0, 0, pa0); PK4(p0, 8, pa1); PK4(p1, 0, pa2); PK4(p1, 8, pa3);
#undef PK4
}
__device__ __forceinline__ void qkt(f32x16& p0, f32x16& p1, const bf16* Ks, const bf16x8* qr, int r32, int hi, float m_ref) {
  { const float nm = -m_ref;
#pragma unroll
    for (int r = 0; r < 16; ++r) { p0[r] = nm; p1[r] = nm; } }
#pragma unroll
  for (int d0 = 0; d0 < 4; ++d0) { int cb = (d0 * 16 + hi * 8) * 2;
    bf16x8 b0 = *reinterpret_cast<const bf16x8*>((const char*)Ks + KSWZ(r32, cb));
    bf16x8 b1 = *reinterpret_cast<const bf16x8*>((const char*)Ks + KSWZ(32 + r32, cb));
    p0 = __builtin_amdgcn_mfma_f32_32x32x16_bf16(b0, qr[d0], p0, 0, 0, 0);
    p1 = __builtin_amdgcn_mfma_f32_32x32x16_bf16(b1, qr[d0], p1, 0, 0, 0); }
}
__device__ __forceinline__ int v_st(int k, int c) { const int kk = (k & ~0xC) | ((k & 4) << 1) | ((k & 8) >> 1); return ((kk >> 3) * 4 + (c >> 5)) * 512 + ((kk & 7) * 32 + (c & 31)) * 2; }
__device__ __forceinline__ int v_rd_base(int lane) { return ((lane & 3) << 3) | (((lane >> 2) & 3) << 6) | (((lane >> 4) & 1) << 5) | (((lane >> 5) & 1) << 8); }
constexpr int v_rd_off(int d0, int ks, int half) { return d0 * 512 + ks * 4096 + half * 2048; }
template <int OFF> __device__ __forceinline__ s16x4 tr_read(int vb) {
  s16x4 r; asm volatile("ds_read_b64_tr_b16 %0, %1 offset:%2" : "=&v"(r) : "v"(vb), "i"(OFF) : "memory"); return r;
}
template <int D0> __device__ __forceinline__ void pv_one(f32x16& od, int vb, bf16x8 pa0, bf16x8 pa1, bf16x8 pa2, bf16x8 pa3) {
  const s16x4 l0 = tr_read<v_rd_off(D0, 0, 0)>(vb), h0 = tr_read<v_rd_off(D0, 0, 1)>(vb), l1 = tr_read<v_rd_off(D0, 1, 0)>(vb), h1 = tr_read<v_rd_off(D0, 1, 1)>(vb);
  const s16x4 l2 = tr_read<v_rd_off(D0, 2, 0)>(vb), h2 = tr_read<v_rd_off(D0, 2, 1)>(vb), l3 = tr_read<v_rd_off(D0, 3, 0)>(vb), h3 = tr_read<v_rd_off(D0, 3, 1)>(vb);
  asm volatile("s_waitcnt lgkmcnt(0)" ::: "memory"); SBAR();
#define PK(L, H) (bf16x8){L[0], L[1], L[2], L[3], H[0], H[1], H[2], H[3]}
  od = __builtin_amdgcn_mfma_f32_32x32x16_bf16(pa0, PK(l0, h0), od, 0, 0, 0);
  od = __builtin_amdgcn_mfma_f32_32x32x16_bf16(pa1, PK(l1, h1), od, 0, 0, 0);
  od = __builtin_amdgcn_mfma_f32_32x32x16_bf16(pa2, PK(l2, h2), od, 0, 0, 0);
  od = __builtin_amdgcn_mfma_f32_32x32x16_bf16(pa3, PK(l3, h3), od, 0, 0, 0);
#undef PK
}
__device__ __forceinline__ void pv_d0(f32x16* o, int vb, bf16x8 pa0, bf16x8 pa1, bf16x8 pa2, bf16x8 pa3) {
  pv_one<0>(o[0], vb, pa0, pa1, pa2, pa3); pv_one<1>(o[1], vb, pa0, pa1, pa2, pa3); pv_one<2>(o[2], vb, pa0, pa1, pa2, pa3); pv_one<3>(o[3], vb, pa0, pa1, pa2, pa3);
}
struct AUnit { const bf16* Q; const bf16* K; const bf16* V; bf16* O; int seq; };
template <class Units> __device__ __forceinline__ void attn_run(const Units& U, char* lds) {
  const int tid = tidx(), wid = tid >> 6, lane = tid & 63, r32 = lane & 31, hi = lane >> 5;
  bf16* V_lds = (bf16*)lds; bf16* K_lds = (bf16*)(lds + 2 * SHM_V);
  float* ws = (float*)(lds + 2 * SHM_V + 2 * SHM_K) + wid * 64; float* li_l = ws; float* al_l = ws + 32;
  const int sr = tid >> 4, sc = (tid & 15) * 8, vst0 = v_st(sr, sc), vst1 = v_st(32 + sr, sc);
  const int kr = tid >> 3, kc = (tid & 7) * 8, kst = KSWZ(kr, kc * 2);
  const int vb0 = (int)(uintptr_t)V_lds + v_rd_base(lane);
  struct { bf16x8 vs0, vs1, ks0; } sr_[2];
  bf16x8 qr[4];
  constexpr int SE = 0, SO = 1;
  const unsigned voff0 = (unsigned)(sr * LD + sc), voff1 = (unsigned)((32 + sr) * LD + sc), koff = (unsigned)(kr * LD + kc);
#define SLOADU(i, UN, k0) do { const bf16* vt_ = (UN).V + (size_t)(k0) * LD; const bf16* kt_ = (UN).K + (size_t)(k0) * LD; \
    sr_[i].vs0 = ld8(vt_ + voff0); sr_[i].vs1 = ld8(vt_ + voff1); sr_[i].ks0 = ld8(kt_ + koff); } while (0)
#define QLOADU(UN) do { const bf16* Qw_ = (UN).Q + (unsigned)((wid * QBLK + r32) * LD + hi * 8); \
    _Pragma("unroll") for (int d0 = 0; d0 < 4; ++d0) qr[d0] = __builtin_nontemporal_load(reinterpret_cast<const bf16x8*>(Qw_ + d0 * 16)); } while (0)
#define SLOAD(i, k0) SLOADU(i, cur, k0)
#define SWRITE(b, i) do { *(bf16x8*)((char*)V_lds + (b) * SHM_V + vst0) = sr_[i].vs0;          \
    *(bf16x8*)((char*)V_lds + (b) * SHM_V + vst1) = sr_[i].vs1;               \
    *(bf16x8*)((char*)K_lds + (b) * SHM_K + kst) = sr_[i].ks0; } while (0)
#define SWAIT() asm volatile("s_waitcnt vmcnt(3)" ::: "memory")
#define RESC(a) do { if (__any((a) < 1.f)) { if (hi == 0) al_l[r32] = (a); asm volatile("s_waitcnt lgkmcnt(0)" ::: "memory"); \
    _Pragma("unroll") for (int d = 0; d < 4; ++d) _Pragma("unroll") for (int r = 0; r < 16; ++r) o[d][r] *= al_l[crow(r, hi)]; } } while (0)
  { AUnit f; if (U.get(0, f)) { SLOADU(SE, f, 0); QLOADU(f); } }
#pragma unroll 1
  for (int ui = 0; ; ++ui) {
    AUnit cur; if (!U.get(ui, cur)) break;
    float m_reg = 0.f, l_reg = 0; f32x16 o[4] = {};
    f32x16 pA0, pA1, pB0, pB1; float alA, alB; bf16x8 pa0, pa1, pa2, pa3; const int NT = cur.seq / KVBLK;
    SWRITE(0, SE); __syncthreads();
    qkt(pA0, pA1, K_lds, qr, r32, hi, 0.f); partialSM<true>(pA0, pA1, m_reg, alA);
    SLOAD(SO, KVBLK); if (2 < NT) SLOAD(SE, 2 * KVBLK);
    SWAIT(); SWRITE(1, SO); __syncthreads();
    for (int j = 1; j + 1 < NT; j += 2) {
      SBAR(); qkt(pB0, pB1, (bf16*)((char*)K_lds + SHM_K), qr, r32, hi, m_reg);
      finishSM(pA0, pA1, alA, l_reg, pa0, pa1, pa2, pa3); SBAR();
      SLOAD(SO, (j + 2) * KVBLK); SBAR();
      pv_d0(o, vb0, pa0, pa1, pa2, pa3); partialSM<false>(pB0, pB1, m_reg, alB);
      __syncthreads(); SWAIT(); SWRITE(0, SE);
      RESC(alB); __syncthreads();
      SBAR(); qkt(pA0, pA1, K_lds, qr, r32, hi, m_reg);
      finishSM(pB0, pB1, alB, l_reg, pa0, pa1, pa2, pa3); SBAR();
      if (j + 3 < NT) SLOAD(SE, (j + 3) * KVBLK); SBAR();
      pv_d0(o, vb0 + (int)SHM_V, pa0, pa1, pa2, pa3); partialSM<false>(pA0, pA1, m_reg, alA);
      __syncthreads(); SWAIT(); SWRITE(1, SO);
      RESC(alA); __syncthreads();
    }
    SBAR(); qkt(pB0, pB1, (bf16*)((char*)K_lds + SHM_K), qr, r32, hi, m_reg);
    finishSM(pA0, pA1, alA, l_reg, pa0, pa1, pa2, pa3); SBAR();
    { AUnit nxt; if (U.get(ui + 1, nxt)) { SLOADU(SE, nxt, 0); QLOADU(nxt); } } SBAR();
    pv_d0(o, vb0, pa0, pa1, pa2, pa3); partialSM<false>(pB0, pB1, m_reg, alB);
    __syncthreads(); RESC(alB);
    finishSM(pB0, pB1, alB, l_reg, pa0, pa1, pa2, pa3); SBAR();
    pv_d0(o, vb0 + (int)SHM_V, pa0, pa1, pa2, pa3);
    if (hi == 0) li_l[r32] = l_reg; asm volatile("s_waitcnt lgkmcnt(0)" ::: "memory");
    float rli[16];
#pragma unroll
    for (int r = 0; r < 16; ++r) rli[r] = __builtin_amdgcn_rcpf(li_l[crow(r, hi)]);
    bf16* Ow = cur.O + (long)(wid * QBLK) * LD;
#pragma unroll
    for (int r = 0; r < 16; ++r) { int orow = crow(r, hi);
#pragma unroll
      for (int d0 = 0; d0 < 4; ++d0) Ow[(long)orow * LD + d0 * 32 + r32] = __float2bfloat16(o[d0][r] * rli[r]); }
    __syncthreads();
  }
#undef SLOADU
#undef QLOADU
#undef SLOAD
#undef SWRITE
#undef SWAIT
#undef RESC
}
#undef KSWZ
#undef SBAR
}

#define FFT_HD __device__ __forceinline__
#ifndef FFT_HD
#define FFT_HD __host__ __device__ __forceinline__
#endif
typedef float cf __attribute__((ext_vector_type(2)));
FFT_HD cf cmul(cf a, cf b) { const cf t = {-a.y, a.x}; return a * b.x + t * b.y; }
FFT_HD cf cmulc(cf a, cf b) { const cf t = {a.y, -a.x}; return a * b.x + t * b.y; }
FFT_HD int fpad(int i) { return i + (i >> 4); }
FFT_HD cf twid(float rev) {
#if defined(__HIP_DEVICE_COMPILE__)
  return cf{__builtin_amdgcn_cosf(rev), -__builtin_amdgcn_sinf(rev)};
#else
  return cf{cosf(6.283185307179586f * rev), -sinf(6.283185307179586f * rev)};
#endif
}
FFT_HD cf rot16(cf d, int k) {
  const float s = 0.70710678119f, c1 = 0.92387953251f, s1 = 0.38268343236f;
  switch (k & 15) {
    case 0: return d;
    case 4: return cf{d.y, -d.x};
    case 8: return cf{-d.x, -d.y};
    case 12: return cf{-d.y, d.x};
    case 2: return cf{(d.x + d.y) * s, (d.y - d.x) * s};
    case 6: return cf{(d.y - d.x) * s, -(d.x + d.y) * s};
    case 10: return cf{-(d.x + d.y) * s, (d.x - d.y) * s};
    case 14: return cf{(d.x - d.y) * s, (d.x + d.y) * s};
    case 1: return cmul(d, cf{c1, -s1});
    case 3: return cmul(d, cf{s1, -c1});
    case 5: return cmul(d, cf{-s1, -c1});
    case 7: return cmul(d, cf{-c1, -s1});
    case 9: return cmul(d, cf{-c1, s1});
    case 11: return cmul(d, cf{-s1, c1});
    case 13: return cmul(d, cf{s1, c1});
    default: return cmul(d, cf{c1, s1});
  }
}
template <int LOG_R, bool UNIT, bool ZHALF> FFT_HD void dif_group(cf (&v)[1 << LOG_R], cf w0) {
  constexpr int R = 1 << LOG_R;
  cf wk = w0;
#pragma unroll
  for (int k = 0; k < LOG_R; ++k) {
    const int half = R >> (k + 1);
#pragma unroll
    for (int m = 0; m < R; ++m) {
      if ((m & half) == 0) {
        const int mm = m & (half - 1);
        cf d;
        if (ZHALF && k == 0) { d = v[m]; }
        else { const cf a = v[m], b = v[m + half]; d = a - b; v[m] = a + b; }
        if (!UNIT) d = cmul(d, wk);
        v[m + half] = rot16(d, (mm << k) * (16 / R));
      }
    }
    if (!UNIT) wk = cmul(wk, wk);
  }
}
template <int LOG_R, bool UNIT, bool LOWONLY> FFT_HD void dit_group(cf (&v)[1 << LOG_R], cf w0) {
  constexpr int R = 1 << LOG_R;
  cf wp[LOG_R];
  wp[0] = w0;
#pragma unroll
  for (int k = 1; k < LOG_R; ++k) wp[k] = cmul(wp[k - 1], wp[k - 1]);
#pragma unroll
  for (int k = LOG_R - 1; k >= 0; --k) {
    const int half = R >> (k + 1);
#pragma unroll
    for (int m = 0; m < R; ++m) {
      if ((m & half) == 0) {
        const int mm = m & (half - 1);
        cf B = rot16(v[m + half], 16 - (mm << k) * (16 / R));
        if (!UNIT) B = cmulc(B, wp[k]);
        const cf A = v[m];
        v[m] = A + B;
        if (!(LOWONLY && k == 0)) v[m + half] = A - B;
      }
    }
  }
}
template <int S> FFT_HD constexpr int goff(int m) { return S >= 16 ? m * S + m * (S / 16) : m * S + ((m * S) >> 4); }
template <bool INV, int LC, class P> FFT_HD void fft_pass8(P a, int NTOT, int tid, int nthr) {
  constexpr int S = LC >> 3;
  static_assert(S >= 8, "fft_pass8: S >= 8");
  for (int g = tid; g < (NTOT >> 3); g += nthr) {
    const int blk = g / S, j = g - blk * S, pb = fpad(blk * LC + j);
    cf v[8];
#pragma unroll
    for (int m = 0; m < 8; ++m) v[m] = a[pb + goff<S>(m)];
    const cf w0 = twid((float)j * (1.0f / (float)LC));
    if (INV) dit_group<3, false, false>(v, w0); else dif_group<3, false, false>(v, w0);
#pragma unroll
    for (int m = 0; m < 8; ++m) a[pb + goff<S>(m)] = v[m];
  }
}
constexpr int DM = 1024, T_ALL = 36864, NGRP = 9, DFF = 2816;
constexpr size_t MiB = 1u << 20;
constexpr size_t WS_MODS = 64 * 1024;
constexpr size_t WS_ROPE = 1008 * 1024;
constexpr size_t WS_HDN2 = 1 * MiB;
constexpr size_t WS_W1 = 4 * MiB, WS_W2 = 10 * MiB, WS_WGU = 12 * MiB, WS_WDN = 23 * MiB;
constexpr size_t WS_H = 29 * MiB;
constexpr size_t WS_BIG = 101 * MiB;
constexpr size_t WS_Q = WS_BIG, WS_K = WS_BIG + 72 * MiB, WS_V = WS_K + 80 * MiB, WS_O1 = WS_V + 80 * MiB;
constexpr size_t WS_U = WS_BIG, WS_VXT = WS_BIG + 216 * MiB;
constexpr size_t WS_ACT = WS_BIG;
constexpr size_t WS_X16 = WS_BIG + 304 * MiB;
constexpr size_t WS_FILT = WS_X16 + 72 * MiB;
constexpr size_t WS_END = WS_FILT + 34 * MiB;
static_assert(WS_END <= 512 * MiB && WS_O1 + 72 * MiB <= WS_X16 && WS_VXT + 72 * MiB <= WS_X16, "ws map");
constexpr int LDS_BYTES = 147456;

typedef unsigned short bf16_t;
typedef float f32x4 __attribute__((ext_vector_type(4)));
typedef unsigned u32x4 __attribute__((ext_vector_type(4)));
typedef unsigned u32x2 __attribute__((ext_vector_type(2)));

struct Params { const float* in[31]; float* out; unsigned char* ws; };
typedef const __attribute__((address_space(4))) unsigned char* kargp_t;
__device__ __forceinline__ unsigned long long karg_u64(int i) {
    const volatile __attribute__((address_space(4))) unsigned* k = (const volatile __attribute__((address_space(4))) unsigned*)__builtin_amdgcn_kernarg_segment_ptr();
    const unsigned lo = __builtin_amdgcn_readfirstlane(k[2 * i]), hi = __builtin_amdgcn_readfirstlane(k[2 * i + 1]);
    return ((unsigned long long)hi << 32) | lo; }
#define GAS1 __attribute__((address_space(1)))
__device__ __forceinline__ const float* INP(int i) { return (const float*)(const GAS1 float*)karg_u64(i); }
__device__ __forceinline__ float* OUTP() { return (float*)(GAS1 float*)karg_u64(31); }
__device__ __forceinline__ unsigned char* WSP() { return (unsigned char*)(GAS1 unsigned char*)karg_u64(32); }
enum { I_XP = 0, I_XS, I_CK, I_CV, I_C, I_CCTX, I_ADAW, I_ADAB, I_N1G, I_N2G, I_WQKV, I_LAM, I_SUBG, I_WO, I_HWIN, I_HBIN, I_HCW, I_HCB,
       I_FW1, I_FB1, I_FW2, I_FB2, I_FW3, I_FB3, I_FFREQ, I_SKIP, I_HWOUT, I_HBOUT, I_WGU, I_WDN, I_FING };

__device__ __forceinline__ unsigned f2bf(float f) { unsigned u = __builtin_bit_cast(unsigned, f); return (u + 0x7fffu + ((u >> 16) & 1u)) >> 16; }
__device__ __forceinline__ unsigned pk2(float lo, float hi) { return f2bf(lo) | (f2bf(hi) << 16); }
__device__ __forceinline__ float bf2f(unsigned short b) { return __builtin_bit_cast(float, (unsigned)b << 16); }
__device__ __forceinline__ float bflo(unsigned w) { return __builtin_bit_cast(float, w << 16); }
__device__ __forceinline__ float bfhi(unsigned w) { return __builtin_bit_cast(float, w & 0xffff0000u); }
template <class T> __device__ __forceinline__ T ldnt(const T* p) { return __builtin_nontemporal_load(p); }
__device__ __forceinline__ float wave_sum(float v) {
#pragma unroll
    for (int o = 1; o < 64; o <<= 1) v += __shfl_xor(v, o);
    return v;
}

__device__ __forceinline__ void transpose_item(const float* W, int K, int N, bf16_t* WT, float* scr, int item, int lane, int mode) {
    const int nblk = N / 32, kb = item / nblk, nb = item % nblk, k0 = 64 * kb, n0 = 32 * nb;
    int n0p = n0;
    if (mode == 1) { const int part = n0 >= DFF ? 1 : 0, jj = n0 - part * DFF; n0p = 256 * (jj >> 7) + 128 * part + (jj & 127); }
#pragma unroll 8
    for (int i = 0; i < 32; ++i) { const int kk = 2 * i + (lane >> 5); scr[kk * 33 + (lane & 31)] = ldnt(W + (size_t)(k0 + kk) * N + n0 + (lane & 31)); }
    __builtin_amdgcn_s_waitcnt(0); asm volatile("" ::: "memory");
    const int c = lane & 7;
#pragma unroll
    for (int j = 0; j < 4; ++j) { const int n = (lane >> 3) + 8 * j; const float* s = scr + (8 * c) * 33 + n;
        u32x4 o; o.x = pk2(s[0 * 33], s[1 * 33]); o.y = pk2(s[2 * 33], s[3 * 33]); o.z = pk2(s[4 * 33], s[5 * 33]); o.w = pk2(s[6 * 33], s[7 * 33]);
        *(u32x4*)(WT + (size_t)(n0p + n) * K + k0 + 8 * c) = o; }
    __builtin_amdgcn_s_waitcnt(0); asm volatile("" ::: "memory");
}
__device__ __forceinline__ void phase_convert_weights(int layer, unsigned char* lds, int which, int bidx, int nblk) {
    const int wid = tidx() >> 6, lane = tidx() & 63;
    float* scr = (float*)(lds + wid * 16384);
    const int gw = bidx * 8 + wid, NGW = nblk * 8;
    const int j = layer >> 1; const bool hy = layer & 1;
    const float* w1 = hy ? INP(I_HWIN) + (size_t)j * 1024 * 3072 : INP(I_WQKV) + (size_t)j * 1024 * 3072;
    const float* w2 = hy ? INP(I_HWOUT) + (size_t)j * 1024 * 1024 : INP(I_WO) + (size_t)j * 1024 * 1024;
    const float* wgu = INP(I_WGU) + (size_t)layer * 1024 * 5632;
    const float* wdn = INP(I_WDN) + (size_t)layer * 2816 * 1024;
    constexpr int I1 = 16 * 96, I2 = 16 * 32, I3 = 16 * 176, I4 = 44 * 32;
    const int lo = which == 2 ? I1 + I2 + I3 : 0, hi = which == 1 ? I1 + I2 + I3 : I1 + I2 + I3 + I4;
    for (int it = lo + gw; it < hi; it += NGW) {
        int r = it;
        if (r < I1) { transpose_item(w1, 1024, 3072, (bf16_t*)(WSP() + WS_W1), scr, r, lane, 0); continue; } r -= I1;
        if (r < I2) { transpose_item(w2, 1024, 1024, (bf16_t*)(WSP() + WS_W2), scr, r, lane, 0); continue; } r -= I2;
        if (r < I3) { transpose_item(wgu, 1024, 5632, (bf16_t*)(WSP() + WS_WGU), scr, r, lane, 1); continue; } r -= I3;
        transpose_item(wdn, 2816, 1024, (bf16_t*)(WSP() + WS_WDN), scr, r, lane, 0);
    }
}

__device__ __forceinline__ void phase0(unsigned char* lds) {
    const int tid = tidx(), wid = tid >> 6, lane = tid & 63;
    {
        float* sc = (float*)lds;
        float* red = (float*)(lds + 9 * 1024 * 4);
        if ((int)blockIdx.x < 192) {
            for (int e = tid; e < 9 * 1024; e += 512) { const int g = e >> 10, k = e & 1023; const float x = g == 0 ? INP(I_CCTX)[k] : INP(I_C)[(g - 1) * 1024 + k];
                sc[e] = x / (1.0f + expf(-x)); }
            __syncthreads();
            for (int it = blockIdx.x; it < 192; it += gridDim.x) {
                const int i = it / 48, chunk = it % 48, cg4 = tid & 31, kl = tid >> 5;
                f32x4 acc[9];
#pragma unroll
                for (int g = 0; g < 9; ++g) acc[g] = (f32x4){0.f, 0.f, 0.f, 0.f};
                const float* wp = INP(I_ADAW) + (size_t)i * 1024 * 6144 + chunk * 128 + cg4 * 4;
                for (int k = kl; k < 1024; k += 16) { const f32x4 w = ldnt((const f32x4*)(wp + (size_t)k * 6144));
#pragma unroll
                    for (int g = 0; g < 9; ++g) acc[g] += w * sc[g * 1024 + k]; }
#pragma unroll
                for (int g = 0; g < 9; ++g) *(f32x4*)(red + (kl * 9 + g) * 128 + cg4 * 4) = acc[g];
                __syncthreads();
                for (int e = tid; e < 9 * 128; e += 512) { const int g = e >> 7, col = e & 127; float s = INP(I_ADAB)[i * 6144 + chunk * 128 + col];
#pragma unroll
                    for (int q = 0; q < 16; ++q) s += red[(q * 9 + g) * 128 + col];
                    ((float*)(WSP() + WS_MODS))[((size_t)i * 9 + g) * 6144 + chunk * 128 + col] = s; }
                __syncthreads();
            }
        }
    }
    {
        const int gw = blockIdx.x * 8 + wid, NGW = gridDim.x * 8;
        for (int idx = gw; idx < 2 * 4352; idx += NGW) {
            const int jh = idx / 4352, r = idx % 4352; const int L = r < 4096 ? 4096 : 256, pos = r < 4096 ? r : r - 4096;
            const float fpos = (float)pos;
            const float tt = fpos / (float)(L - 1);
            const float w = 6.283185307179586f * fpos / (float)L;
            float z;
            { const int bi = lane == 0 ? 0 : ((lane - 1) & 15); const float band = 1e-4f + (float)bi * ((15.0f - 1e-4f) / 15.0f); const float a = w * band;
              z = lane == 0 ? tt : (lane <= 16 ? cosf(a) : -sinf(a)); }
            const float* w1 = INP(I_FW1) + (size_t)jh * 33 * 64; const float* w2 = INP(I_FW2) + (size_t)jh * 64 * 64;
            const float fr = INP(I_FFREQ)[jh * 64 + lane];
            float a1 = INP(I_FB1)[jh * 64 + lane];
            for (int f = 0; f < 33; ++f) a1 += __shfl(z, f) * w1[f * 64 + lane];
            const float h1 = sinf(fr * a1);
            float a2 = INP(I_FB2)[jh * 64 + lane];
            for (int k = 0; k < 64; ++k) a2 += __shfl(h1, k) * w2[k * 64 + lane];
            ((float*)(WSP() + WS_HDN2))[(size_t)idx * 64 + lane] = sinf(fr * a2);
        }
    }
    if (blockIdx.x == gridDim.x - 1) {
        for (int e = tid; e < 1024; e += 512) { const int posi = e >> 4, f = e & 15; const float inv = powf(10000.0f, -(float)f / 16.0f); const float ang = (float)posi * inv;
            ((float*)(WSP() + WS_ROPE))[e] = cosf(ang); ((float*)(WSP() + WS_ROPE))[1024 + e] = sinf(ang); }
    }
}

__device__ __forceinline__ void phase_norm(const float* gamma, const float* mods_l, int shift_idx, bool first) {
    const int wid = tidx() >> 6, lane = tidx() & 63;
    const int gw = blockIdx.x * 8 + wid, NGW = gridDim.x * 8;
    bf16_t* H = (bf16_t*)(WSP() + WS_H);
    const float* xc = INP(I_XP); const float* xm = INP(I_XS); const bf16_t* X16 = (const bf16_t*)(WSP() + WS_X16);
    f32x4 gm[4];
#pragma unroll
    for (int j = 0; j < 4; ++j) gm[j] = *(const f32x4*)(gamma + 4 * lane + 256 * j);
    for (int row0 = gw; row0 < T_ALL; row0 += 2 * NGW) {
        f32x4 v[2][4]; float s[2];
#pragma unroll
        for (int q = 0; q < 2; ++q) { const int row = row0 + q * NGW; s[q] = 0.f;
            if (row < T_ALL) {
                if (first) { const f32x4* xr = (const f32x4*)(row < 4096 ? xc + (size_t)row * 1024 : xm + (size_t)(row - 4096) * 1024) + lane;
#pragma unroll
                    for (int j = 0; j < 4; ++j) v[q][j] = ldnt(xr + 64 * j); }
                else { const u32x2* xr = (const u32x2*)(X16 + (size_t)row * 1024) + lane;
#pragma unroll
                    for (int j = 0; j < 4; ++j) { const u32x2 w = ldnt(xr + 64 * j); v[q][j] = (f32x4){bflo(w.x), bfhi(w.x), bflo(w.y), bfhi(w.y)}; } }
#pragma unroll
                for (int j = 0; j < 4; ++j) s[q] += (v[q][j].x * v[q][j].x + v[q][j].y * v[q][j].y) + (v[q][j].z * v[q][j].z + v[q][j].w * v[q][j].w); } }
#pragma unroll
        for (int q = 0; q < 2; ++q) { const int row = row0 + q * NGW;
            if (row < T_ALL) {
                const float* mp = mods_l + (size_t)(row >> 12) * 6144;
                const float rstd = 1.0f / sqrtf(wave_sum(s[q]) * (1.0f / 1024.0f) + 1e-6f);
                u32x2* o = (u32x2*)(H + (size_t)row * 1024) + lane;
#pragma unroll
                for (int j = 0; j < 4; ++j) { const f32x4 sh = *(const f32x4*)(mp + shift_idx * 1024 + 4 * lane + 256 * j), scl = *(const f32x4*)(mp + (shift_idx + 1) * 1024 + 4 * lane + 256 * j);
                    const f32x4 y = v[q][j] * rstd * gm[j] * (scl + 1.0f) + sh;
                    u32x2 w; w.x = pk2(y.x, y.y); w.y = pk2(y.z, y.w); o[64 * j] = w; } } }
    }
}
__device__ __forceinline__ void phase_final_norm() {
    const int wid = tidx() >> 6, lane = tidx() & 63;
    const int gw = blockIdx.x * 8 + wid, NGW = gridDim.x * 8;
    const float* gamma = INP(I_FING); const bf16_t* X16 = (const bf16_t*)(WSP() + WS_X16);
    f32x4 gm[4];
#pragma unroll
    for (int j = 0; j < 4; ++j) gm[j] = *(const f32x4*)(gamma + 4 * lane + 256 * j);
    for (int row = gw; row < T_ALL; row += NGW) {
        const u32x2* xr = (const u32x2*)(X16 + (size_t)row * 1024) + lane;
        f32x4 v[4]; float s = 0.f;
#pragma unroll
        for (int j = 0; j < 4; ++j) { const u32x2 w = xr[64 * j]; v[j] = (f32x4){bflo(w.x), bfhi(w.x), bflo(w.y), bfhi(w.y)}; s += (v[j].x * v[j].x + v[j].y * v[j].y) + (v[j].z * v[j].z + v[j].w * v[j].w); }
        const float rstd = 1.0f / sqrtf(wave_sum(s) * (1.0f / 1024.0f) + 1e-6f);
        f32x4* o = (f32x4*)(OUTP() + (size_t)row * 1024) + lane;
#pragma unroll
        for (int j = 0; j < 4; ++j) __builtin_nontemporal_store(v[j] * rstd * gm[j], o + 64 * j);
    }
}
__device__ __forceinline__ void phase_cache_convert(int j) {
    bf16_t* Kb = (bf16_t*)(WSP() + WS_K); bf16_t* Vb = (bf16_t*)(WSP() + WS_V);
    const size_t n8 = (size_t)8 * 512 * 1024 / 8;
    for (size_t i = (size_t)blockIdx.x * 512 + tidx(); i < 2 * n8; i += (size_t)gridDim.x * 512) {
        const bool isv = i >= n8; const size_t e = (isv ? i - n8 : i) * 8; const int b = (int)(e / (512 * 1024)); const size_t rem = e % (512 * 1024);
        const float* src = (isv ? INP(I_CV) : INP(I_CK)) + ((size_t)(b * 2 + j) * 512 * 1024) + rem;
        const f32x4 a = ldnt((const f32x4*)src), c = ldnt((const f32x4*)(src + 4));
        u32x4 w; w.x = pk2(a.x, a.y); w.y = pk2(a.z, a.w); w.z = pk2(c.x, c.y); w.w = pk2(c.z, c.w);
        *(u32x4*)((isv ? Vb : Kb) + (size_t)(4096 + b * 4608) * 1024 + rem) = w;
    }
}
struct AttnUnits {
    int vcu, G;
    __device__ __forceinline__ bool get(int i, attn::AUnit& u) const {
        const int id = vcu + i * G; if (id >= 2048 + 256) return false;
        int b, h, mp; size_t qrow, krow;
        if (id < 2048) { const int bh = id >> 5, r = id & 31; b = bh >> 3; h = bh & 7; mp = r >> 4; const int qb = r & 15; u.seq = 4608;
            qrow = (size_t)4096 + (size_t)b * 4096 + qb * 256; krow = (size_t)4096 + (size_t)b * 4608; }
        else { const int r = id - 2048; b = r >> 4; h = (r >> 1) & 7; mp = r & 1; u.seq = 256; qrow = (size_t)b * 256; krow = qrow; }
        unsigned char* ws = WSP();
        u.Q = (const attn::bf16*)(ws + WS_Q) + qrow * 1024 + h * 128 + mp * 64; u.K = (const attn::bf16*)(ws + WS_K) + krow * 1024 + h * 128 + mp * 64; u.V = (const attn::bf16*)(ws + WS_V) + krow * 1024 + h * 128;
        u.O = (attn::bf16*)(ws + (mp ? WS_O1 : WS_H)) + qrow * 1024 + h * 128; return true;
    }
};
__device__ __forceinline__ void phase_attention(unsigned char* lds) {
    const int G = gridDim.x, bx = blockIdx.x; const int vcu = (G % 8 == 0) ? (bx % 8) * (G / 8) + bx / 8 : bx;
    AttnUnits U{vcu, G};
    attn::attn_run(U, (char*)lds);
}
__device__ __forceinline__ void phase_combine(int layer) {
    const int wid = tidx() >> 6, lane = tidx() & 63;
    const int gw = blockIdx.x * 8 + wid, NGW = gridDim.x * 8;
    const int j = layer >> 1;
    const float* lp = INP(I_LAM) + (size_t)j * 4 * 64;
    const float s1 = wave_sum(lp[lane] * lp[64 + lane]), s2 = wave_sum(lp[128 + lane] * lp[192 + lane]);
    const float lam_init = 0.8f - 0.6f * expf(-0.3f * (float)layer);
    const float lam = expf(s1) - expf(s2) + lam_init;
    const float osc = 1.0f - lam_init;
    bf16_t* O0 = (bf16_t*)(WSP() + WS_H); const bf16_t* O1 = (const bf16_t*)(WSP() + WS_O1);
    float gsub[16];
#pragma unroll
    for (int e = 0; e < 16; ++e) gsub[e] = INP(I_SUBG)[j * 128 + (lane & 7) * 16 + e] * osc;
    for (int row = gw; row < T_ALL; row += NGW) {
        u32x4* a = (u32x4*)(O0 + (size_t)row * 1024) + lane * 2; const u32x4* c = (const u32x4*)(O1 + (size_t)row * 1024) + lane * 2;
        const u32x4 a0 = ldnt((const u32x4*)a), a1 = ldnt((const u32x4*)a + 1), c0 = ldnt(c), c1 = ldnt(c + 1);
        float v[16];
#pragma unroll
        for (int q = 0; q < 4; ++q) { v[2 * q] = bflo(a0[q]) - lam * bflo(c0[q]); v[2 * q + 1] = bfhi(a0[q]) - lam * bfhi(c0[q]);
            v[8 + 2 * q] = bflo(a1[q]) - lam * bflo(c1[q]); v[8 + 2 * q + 1] = bfhi(a1[q]) - lam * bfhi(c1[q]); }
        float s = 0.f;
#pragma unroll
        for (int e = 0; e < 16; ++e) s += v[e] * v[e];
        s += __shfl_xor(s, 1); s += __shfl_xor(s, 2); s += __shfl_xor(s, 4);
        const float rstd = 1.0f / sqrtf(s * (1.0f / 128.0f) + 1e-5f);
        u32x4 w0, w1;
#pragma unroll
        for (int q = 0; q < 4; ++q) { w0[q] = pk2(v[2 * q] * rstd * gsub[2 * q], v[2 * q + 1] * rstd * gsub[2 * q + 1]);
            w1[q] = pk2(v[8 + 2 * q] * rstd * gsub[8 + 2 * q], v[8 + 2 * q + 1] * rstd * gsub[8 + 2 * q + 1]); }
        a[0] = w0; a[1] = w1;
    }
}
__device__ __forceinline__ size_t vxt_index(int row, int c) {
    return row < 4096 ? ((size_t)((row >> 8) * 1024 + c) * 256 + (row & 255)) : ((size_t)4096 * 1024 + ((size_t)(((row - 4096) >> 12) * 1024 + c) * 4096) + (row & 4095));
}
__device__ __forceinline__ void unpack8(const u32x4 w, float* f) {
#pragma unroll
    for (int q = 0; q < 4; ++q) { f[2 * q] = bflo(w[q]); f[2 * q + 1] = bfhi(w[q]); }
}
__device__ __forceinline__ void phase_conv3(int jh, unsigned char* lds) {
    const int tid = tidx();
    const bf16_t* U = (const bf16_t*)(WSP() + WS_U); bf16_t* X0 = (bf16_t*)(WSP() + WS_H); bf16_t* VXT = (bf16_t*)(WSP() + WS_VXT);
    float* tile = (float*)lds;
    const float* cw = INP(I_HCW) + (size_t)jh * 3 * 3072; const float* cb = INP(I_HCB) + (size_t)jh * 3072;
    const int tl = tid >> 3, c8 = (tid & 7) * 8;
    for (int it = blockIdx.x; it < 576 * 8; it += gridDim.x) {
        const int tt = it >> 3, ct = it & 7; const int row = tt * 64 + tl;
        const int L = row < 4096 ? 256 : 4096; const int ts = row & (L - 1);
        const bool hasp = ts > 0, hasn = ts < L - 1;
        u32x4 uc[2][3], um[2][3], un[2][3];
#pragma unroll
        for (int hf = 0; hf < 2; ++hf)
#pragma unroll
            for (int part = 1; part < 3; ++part) {
                const bf16_t* up = U + (size_t)row * 3072 + part * 1024 + ct * 128 + hf * 64 + c8;
                uc[hf][part] = ldnt((const u32x4*)up);
                um[hf][part] = hasp ? ldnt((const u32x4*)(up - 3072)) : (u32x4){0u, 0u, 0u, 0u};
                un[hf][part] = hasn ? ldnt((const u32x4*)(up + 3072)) : (u32x4){0u, 0u, 0u, 0u};
            }
#pragma unroll
        for (int hf = 0; hf < 2; ++hf) {
            const int c0 = ct * 128 + hf * 64 + c8;
            float res[3][8];
#pragma unroll
            for (int part = 1; part < 3; ++part) {
                const int col = part * 1024 + c0;
                float fm[8], fc[8], fn[8]; unpack8(um[hf][part], fm); unpack8(uc[hf][part], fc); unpack8(un[hf][part], fn);
#pragma unroll
                for (int e = 0; e < 8; ++e) res[part][e] = fm[e] * cw[col + e] + fc[e] * cw[3072 + col + e] + fn[e] * cw[6144 + col + e] + cb[col + e];
            }
#pragma unroll
            for (int e = 0; e < 8; ++e) tile[(hf * 64 + c8 + e) * 65 + tl] = res[2][e] * res[1][e];
        }
        __syncthreads();
#pragma unroll
        for (int hf = 0; hf < 2; ++hf) { const int cl = hf * 64 + (tid >> 3), t8 = (tid & 7) * 8; const int r0 = tt * 64 + t8, c = ct * 128 + cl;
          f32x4 a, b; a.x = tile[cl * 65 + t8]; a.y = tile[cl * 65 + t8 + 1]; a.z = tile[cl * 65 + t8 + 2]; a.w = tile[cl * 65 + t8 + 3];
          b.x = tile[cl * 65 + t8 + 4]; b.y = tile[cl * 65 + t8 + 5]; b.z = tile[cl * 65 + t8 + 6]; b.w = tile[cl * 65 + t8 + 7];
          u32x4 w; w.x = pk2(a.x, a.y); w.y = pk2(a.z, a.w); w.z = pk2(b.x, b.y); w.w = pk2(b.z, b.w); *(u32x4*)(VXT + vxt_index(r0, c)) = w; }
        __syncthreads();
    }
}
__device__ __forceinline__ void phase_gate(int jh, unsigned char* lds) {
    const int tid = tidx();
    bf16_t* Z = (bf16_t*)(WSP() + WS_H); const bf16_t* VXT = (const bf16_t*)(WSP() + WS_VXT); const bf16_t* U = (const bf16_t*)(WSP() + WS_U);
    const float* cw = INP(I_HCW) + (size_t)jh * 3 * 3072; const float* cb = INP(I_HCB) + (size_t)jh * 3072;
    float* tile = (float*)lds;
    for (int it = blockIdx.x; it < 576 * 8; it += gridDim.x) {
        const int tt = it >> 3, ct = it & 7;
        const int tl = tid >> 3, c8 = (tid & 7) * 8; const int row = tt * 64 + tl;
        const int L = row < 4096 ? 256 : 4096; const int ts = row & (L - 1);
        const bool hasp = ts > 0, hasn = ts < L - 1;
        f32x4 ya[2], yb[2]; u32x4 uc[2], um[2], un[2];
#pragma unroll
        for (int hf = 0; hf < 2; ++hf) { const int cl = hf * 64 + (tid >> 3), t8 = (tid & 7) * 8; const int r0 = tt * 64 + t8, c = ct * 128 + cl;
          const u32x4 w = ldnt((const u32x4*)(VXT + vxt_index(r0, c))); ya[hf] = (f32x4){bflo(w.x), bfhi(w.x), bflo(w.y), bfhi(w.y)}; yb[hf] = (f32x4){bflo(w.z), bfhi(w.z), bflo(w.w), bfhi(w.w)}; }
#pragma unroll
        for (int hf = 0; hf < 2; ++hf) { const bf16_t* up = U + (size_t)row * 3072 + ct * 128 + hf * 64 + c8;
          uc[hf] = ldnt((const u32x4*)up); um[hf] = hasp ? ldnt((const u32x4*)(up - 3072)) : (u32x4){0u, 0u, 0u, 0u}; un[hf] = hasn ? ldnt((const u32x4*)(up + 3072)) : (u32x4){0u, 0u, 0u, 0u}; }
#pragma unroll
        for (int hf = 0; hf < 2; ++hf) { const int cl = hf * 64 + (tid >> 3), t8 = (tid & 7) * 8;
          tile[(t8 + 0) * 129 + cl] = ya[hf].x; tile[(t8 + 1) * 129 + cl] = ya[hf].y; tile[(t8 + 2) * 129 + cl] = ya[hf].z; tile[(t8 + 3) * 129 + cl] = ya[hf].w;
          tile[(t8 + 4) * 129 + cl] = yb[hf].x; tile[(t8 + 5) * 129 + cl] = yb[hf].y; tile[(t8 + 6) * 129 + cl] = yb[hf].z; tile[(t8 + 7) * 129 + cl] = yb[hf].w; }
        __syncthreads();
#pragma unroll
        for (int hf = 0; hf < 2; ++hf) { const int cc = hf * 64 + c8, col = ct * 128 + cc;
          float fm[8], fc[8], fn[8]; unpack8(um[hf], fm); unpack8(uc[hf], fc); unpack8(un[hf], fn);
          float r[8];
#pragma unroll
          for (int e = 0; e < 8; ++e) { const float x0 = fm[e] * cw[col + e] + fc[e] * cw[3072 + col + e] + fn[e] * cw[6144 + col + e] + cb[col + e]; r[e] = x0 * tile[tl * 129 + cc + e]; }
          u32x4 w; w.x = pk2(r[0], r[1]); w.y = pk2(r[2], r[3]); w.z = pk2(r[4], r[5]); w.w = pk2(r[6], r[7]); *(u32x4*)(Z + (size_t)row * 1024 + col) = w; }
        __syncthreads();
    }
}
__device__ __forceinline__ void phase_filter(int jh, unsigned char* lds, int bidx, int nblk) {
    const int tid = tidx(), lx = tid & 63, cgp = tid >> 6;
    float* hs = (float*)lds;
    float* w3s = (float*)(lds + 64 * 65 * 4);
    const float* tab = (const float*)(WSP() + WS_HDN2) + (size_t)jh * 4352 * 64;
    const float* w3 = INP(I_FW3) + (size_t)jh * 64 * 2048; const float* b3 = INP(I_FB3) + jh * 2048;
    float* hT = (float*)(WSP() + WS_FILT);
    __syncthreads();
    for (int it = bidx; it < 68 * 8; it += nblk) {
        const int lt = it >> 3, ctile = it & 7; const int l0 = lt * 64, col0 = ctile * 256;
        for (int e = tid; e < 64 * 64; e += 512) hs[(e >> 6) * 65 + (e & 63)] = tab[(size_t)l0 * 64 + e];
        for (int e = tid; e < 64 * 256; e += 512) w3s[e] = w3[(size_t)(e >> 8) * 2048 + col0 + (e & 255)];
        __syncthreads();
        float acc[32];
#pragma unroll
        for (int q = 0; q < 32; ++q) acc[q] = 0.f;
#pragma unroll 4
        for (int k = 0; k < 64; ++k) { const float hv = hs[lx * 65 + k]; const f32x4* wr = (const f32x4*)(w3s + k * 256 + cgp * 32);
#pragma unroll
            for (int q = 0; q < 8; ++q) { const f32x4 w = wr[q]; acc[4 * q] += hv * w.x; acc[4 * q + 1] += hv * w.y; acc[4 * q + 2] += hv * w.z; acc[4 * q + 3] += hv * w.w; } }
        const int r = l0 + lx; const int L = r < 4096 ? 4096 : 256, pos = r < 4096 ? r : r - 4096;
        const float tl = (float)pos / (float)(L - 1);
        float* ob = r < 4096 ? hT : hT + (size_t)1024 * 2 * 4096;
#pragma unroll
        for (int q = 0; q < 32; ++q) { const int col = col0 + cgp * 32 + q, dir = col >> 10, c = col & 1023;
            const float delta = fabsf(-3.0701134573253945f + (-15.350567286626973f + 3.0701134573253945f) * ((float)c / 1023.0f));
            ob[(size_t)(c * 2 + dir) * L + pos] = (acc[q] + b3[col]) * expf(-tl * delta); }
        __syncthreads();
    }
}
template <bool INV, int LOG_N> __device__ __forceinline__ void fft_mid(cf* a, int NTOT, int tid) {
    if constexpr (LOG_N == 13) {
        if (!INV) { fft_pass8<false, 1024>(a, NTOT, tid, 512); __syncthreads(); fft_pass8<false, 128>(a, NTOT, tid, 512); __syncthreads(); }
        else { fft_pass8<true, 128>(a, NTOT, tid, 512); __syncthreads(); fft_pass8<true, 1024>(a, NTOT, tid, 512); __syncthreads(); }
    } else { fft_pass8<INV, 64>(a, NTOT, tid, 512); __syncthreads(); }
}
template <int LOG_N>
__device__ __forceinline__ void hyena_fft_unit(int jh, int c, unsigned char* lds, bool dry) {
    constexpr int N = 1 << LOG_N, L = N / 2, LOG_L = LOG_N - 1, LOG_LAST = (LOG_N % 3 == 1) ? 4 : 3, RL = 1 << LOG_LAST, S0 = N / 8;
    constexpr int NAR = (LOG_N == 13) ? 2 : 8, NRND = (LOG_N == 13) ? 2 : 1, NTOT = NAR * N;
    const int tid = tidx();
    cf* a = (cf*)lds;
    float* wl = (float*)(lds + 139264);
    bf16_t* vbase = (bf16_t*)(WSP() + WS_VXT) + (LOG_N == 13 ? (size_t)4096 * 1024 : 0);
    const float* hT = (const float*)(WSP() + WS_FILT) + (LOG_N == 13 ? (size_t)0 : (size_t)1024 * 2 * 4096) + (size_t)c * 2 * L;
    float asum = 0.f;
#pragma unroll 4
    for (int i = tid; i < N; i += 512) {
        const float hv = i < L ? hT[i] : hT[L + (i == L ? 0 : N - i)];
        asum += fabsf(hv);
        a[fpad(i)] = cf{i == L ? 0.f : hv, 0.f};
    }
    asum = wave_sum(asum);
    if ((tid & 63) == 0) wl[136 + (tid >> 6)] = asum;
    __syncthreads();
    float tot = 0.f;
#pragma unroll
    for (int q = 0; q < 8; ++q) tot += wl[136 + q];
    const float fs = 1.0f / ((tot + 1e-6f) * (float)N);
    fft_pass8<false, N>(a, N, tid, 512); __syncthreads();
    fft_mid<false, LOG_N>(a, N, tid);
    cf kreg[RL];
    { const int pb = fpad((tid % (N >> LOG_LAST)) * RL);
#pragma unroll
      for (int e = 0; e < RL; ++e) kreg[e] = a[pb + e];
      dif_group<LOG_LAST, true, false>(kreg, cf{1.f, 0.f}); }
    __syncthreads();
    const float skipc = INP(I_SKIP)[jh * 1024 + c];
#pragma unroll 1
    for (int rd = 0; rd < NRND; ++rd) {
        for (int g = tid; g < NTOT / 8; g += 512) {
            const int arr = g / S0, j = g - arr * S0; const int sq = 2 * (rd * NAR + arr);
            const bf16_t* p0 = vbase + (((size_t)sq * 1024 + c) << LOG_L) + j; const bf16_t* p1 = p0 + ((size_t)1024 << LOG_L);
            cf x[8];
#pragma unroll
            for (int m = 0; m < 4; ++m) x[m] = cf{bf2f(p0[m * S0]), bf2f(p1[m * S0])};
#pragma unroll
            for (int m = 4; m < 8; ++m) x[m] = cf{0.f, 0.f};
            dif_group<3, false, true>(x, twid((float)j * (1.0f / (float)N)));
            const int pb = fpad(arr * N + j);
#pragma unroll
            for (int m = 0; m < 8; ++m) a[pb + goff<S0>(m)] = x[m];
        }
        __syncthreads();
        fft_mid<false, LOG_N>(a, NTOT, tid);
        for (int g = tid; g < (NTOT >> LOG_LAST); g += 512) {
            cf x[RL]; const int pb = fpad(g << LOG_LAST);
#pragma unroll
            for (int e = 0; e < RL; ++e) x[e] = a[pb + e];
            dif_group<LOG_LAST, true, false>(x, cf{1.f, 0.f});
#pragma unroll
            for (int e = 0; e < RL; ++e) x[e] = cmul(x[e], kreg[e]);
            dit_group<LOG_LAST, true, false>(x, cf{1.f, 0.f});
#pragma unroll
            for (int e = 0; e < RL; ++e) a[pb + e] = x[e];
        }
        __syncthreads();
        fft_mid<true, LOG_N>(a, NTOT, tid);
        for (int g = tid; g < NTOT / 8; g += 512) {
            const int arr = g / S0, j = g - arr * S0; const int sq = 2 * (rd * NAR + arr);
            bf16_t* p0 = vbase + (((size_t)sq * 1024 + c) << LOG_L) + j; bf16_t* p1 = p0 + ((size_t)1024 << LOG_L);
            cf x[8]; const int pb = fpad(arr * N + j);
#pragma unroll
            for (int m = 0; m < 8; ++m) x[m] = a[pb + goff<S0>(m)];
            dit_group<3, false, true>(x, twid((float)j * (1.0f / (float)N)));
#pragma unroll
            for (int m = 0; m < 4; ++m) { const float v0 = bf2f(p0[m * S0]), v1 = bf2f(p1[m * S0]); const float y0 = x[m].x * fs + v0 * skipc, y1 = x[m].y * fs + v1 * skipc; if (!dry || y0 == 1.2345e30f) { p0[m * S0] = (bf16_t)f2bf(y0); p1[m * S0] = (bf16_t)f2bf(y1); } }
        }
        __syncthreads();
    }
}
__device__ __forceinline__ void phase_fft(int jh, unsigned char* lds, bool dry) {
    for (int it = blockIdx.x; it < 2048; it += gridDim.x) {
        if (it < 1024) hyena_fft_unit<13>(jh, it, lds, dry); else hyena_fft_unit<9>(jh, it - 1024, lds, dry);
    }
}
#define LAS __attribute__((address_space(3)))
#define XB_TMO      128
#define XB_XCNT(j)  (256  + 64 * (j))
#define XB_XSUB(j)  (1280 + 64 * (j))
#define XB_XGEN(j)  (2304 + 64 * (j))
#define XB_TOP      3328
#define XB_TOPGEN   3392
#define XCD_BAR_WORDS 3456
#define XB_SPIN_CAP (1u << 18)

__device__ __forceinline__ unsigned xb_ld(unsigned* p)              { return __hip_atomic_load(p, __ATOMIC_RELAXED, __HIP_MEMORY_SCOPE_AGENT); }
__device__ __forceinline__ unsigned xb_add(unsigned* p, unsigned v) { return __hip_atomic_fetch_add(p, v, __ATOMIC_RELAXED, __HIP_MEMORY_SCOPE_AGENT); }
__device__ __forceinline__ unsigned xb_xcc_id() { return (unsigned)__builtin_amdgcn_s_getreg((3 << 11) | 20) & 0xFu; }
#define XB_SPIN(cond, bar) do { unsigned _sp = 0; while (cond) { __builtin_amdgcn_s_sleep(1); \
    if ((++_sp & 255u) == 0u) { if (xb_ld(&(bar)[XB_TMO])) break; if (_sp > XB_SPIN_CAP) { atomicAdd(&(bar)[XB_TMO], 1u); break; } } } } while (0)

struct XcdBarrier {
    unsigned* bar; unsigned x;
    volatile LAS unsigned* st;
};

__device__ __forceinline__ XcdBarrier xcd_barrier_post(unsigned* bar, volatile LAS unsigned* st) {
    XcdBarrier b; b.bar = bar; b.x = xb_xcc_id(); b.st = st;
    if (threadIdx.x == 0) (void)xb_add(&bar[XB_XCNT(b.x)], 1u);
    return b;
}
__device__ __forceinline__ void xcd_barrier_complete(unsigned* bar, unsigned x, unsigned& nloc, unsigned& nx) {
    const unsigned G = gridDim.x * gridDim.y * gridDim.z;
    unsigned sum, cnt, mine, sp = 0u;
    for (;;) {
        sum = 0u; cnt = 0u; mine = 0u;
#pragma unroll
        for (unsigned j = 0; j < 16; ++j) { const unsigned c = xb_ld(&bar[XB_XCNT(j)]); sum += c; cnt += (c > 0u) ? 1u : 0u; mine = (j == x) ? c : mine; }
        if (sum == G) break;
        __builtin_amdgcn_s_sleep(1);
        if ((++sp & 255u) == 0u) { if (xb_ld(&bar[XB_TMO])) break; if (sp > XB_SPIN_CAP) { atomicAdd(&bar[XB_TMO], 1u); break; } }
    }
    nloc = mine > 0u ? mine : 1u; nx = cnt > 0u ? cnt : 1u;
}

__device__ __forceinline__ void xcd_barrier(const XcdBarrier& b) {
    asm volatile("s_waitcnt vmcnt(0)" ::: "memory");
    __syncthreads();
    if (threadIdx.x == 0) {
        unsigned* bar = b.bar;
        __builtin_amdgcn_s_waitcnt(0);
        unsigned nloc = b.st[0], nx = b.st[1];
        if (nloc == 0u) { xcd_barrier_complete(bar, b.x, nloc, nx); b.st[0] = nloc; b.st[1] = nx; }
        const unsigned old = xb_add(&bar[XB_XSUB(b.x)], 1u);
        const unsigned gen = old / nloc;
        if (old + 1u == (gen + 1u) * nloc) {
            __builtin_amdgcn_fence(__ATOMIC_RELEASE, "agent");
            asm volatile("s_waitcnt vmcnt(0)" ::: "memory");
            const unsigned og = xb_add(&bar[XB_TOP], 1u);
            const unsigned tg = og / nx;
            if (og + 1u == (tg + 1u) * nx) xb_add(&bar[XB_TOPGEN], 1u);
            else XB_SPIN(xb_ld(&bar[XB_TOPGEN]) == tg, bar);
            __builtin_amdgcn_fence(__ATOMIC_ACQUIRE, "agent");
            xb_add(&bar[XB_XGEN(b.x)], 1u);
            asm volatile("s_waitcnt vmcnt(0)" ::: "memory");
        } else {
            XB_SPIN(xb_ld(&bar[XB_XGEN(b.x)]) == gen, bar);
            __builtin_amdgcn_fence(__ATOMIC_ACQUIRE, "agent");
            asm volatile("s_waitcnt vmcnt(0)" ::: "memory");
        }
    }
    __syncthreads();
}
__global__ void __launch_bounds__(512, 2) fwd_megakernel(Params p) {
    extern __shared__ __attribute__((aligned(16))) unsigned char lds[];
    cg::grid_group grid = cg::this_grid();
    const int G = gridDim.x;
    { volatile LAS unsigned* st0 = (volatile LAS unsigned*)((LAS unsigned char*)lds + (LDS_BYTES - 64)); if (tidx() < 2) st0[tidx() & 1] = 0u;
      if (blockIdx.x == 0) { unsigned* bw = (unsigned*)(WSP()); for (int i = tidx(); i < XCD_BAR_WORDS; i += 512) __hip_atomic_store(bw + i, 0u, __ATOMIC_RELAXED, __HIP_MEMORY_SCOPE_AGENT); }
      __syncthreads(); }
#define GSYNC() do { XcdBarrier b_; b_.bar = (unsigned*)(WSP()); b_.x = xb_xcc_id(); b_.st = (volatile LAS unsigned*)((LAS unsigned char*)lds + (LDS_BYTES - 64)); xcd_barrier(b_); } while (0)
#ifndef NO_P0
    phase0(lds);
#ifdef PROBE_P0
    __syncthreads(); phase0(lds); __syncthreads(); phase0(lds);
#endif
#endif
    grid.sync();
    (void)xcd_barrier_post((unsigned*)(WSP()), (volatile LAS unsigned*)((LAS unsigned char*)lds + (LDS_BYTES - 64)));
#pragma unroll 1
    for (int s = 0; s < 8; ++s) {
        const int layer = s >> 1; const bool isffn = s & 1, ishy = layer & 1; const int j = layer >> 1;
        unsigned char* ws = WSP();
        const float* mods_l = (const float*)(ws + WS_MODS) + (size_t)layer * 9 * 6144;
        const bool early = (G == 256) && layer > 0;
        if (!isffn) { phase_convert_weights(layer, lds, early ? 2 : 0, (int)blockIdx.x, G); if (!ishy) phase_cache_convert(j); }
        if (!isffn && ishy && !early) phase_filter(j, lds, (int)blockIdx.x, G);
        phase_norm((isffn ? INP(I_N2G) : INP(I_N1G)) + layer * 1024, mods_l, isffn ? 3 : 0, s == 0);
        GSYNC();
        if (isffn) {
            pg8::Gemm g{(const pg8::bf16_t*)(ws + WS_H), (const pg8::bf16_t*)(ws + WS_WGU), T_ALL, 2 * DFF, 1024}; pg8::StaticOrder S; S.init(T_ALL, 2 * DFF, G, (int)blockIdx.x);
            pg8::EpiSwiglu E{(pg8::bf16_t*)(ws + WS_ACT)};
            #ifndef NO_G1
pg8::gemm_phase<pg8::EpiSwiglu, pg8::StaticOrder, true, true>((PG8_LAS unsigned char*)lds, g, S, E);
#ifdef PROBE_G1
            pg8::gemm_phase<pg8::EpiSwiglu, pg8::StaticOrder, true, true>((PG8_LAS unsigned char*)lds, g, S, E);
#endif
#endif
        } else if (ishy) {
            pg8::Gemm g{(const pg8::bf16_t*)(ws + WS_H), (const pg8::bf16_t*)(ws + WS_W1), T_ALL, 3072, 1024}; pg8::StaticOrder S; S.init(T_ALL, 3072, G, (int)blockIdx.x);
            pg8::EpiBf16 E{(pg8::bf16_t*)(ws + WS_U), 3072, INP(I_HBIN) + (size_t)j * 3072};
            #ifndef NO_G2
pg8::gemm_phase<pg8::EpiBf16, pg8::StaticOrder, true, true>((PG8_LAS unsigned char*)lds, g, S, E);
#ifdef PROBE_G1
            pg8::gemm_phase<pg8::EpiBf16, pg8::StaticOrder, true, true>((PG8_LAS unsigned char*)lds, g, S, E);
#endif
#endif
        } else {
            pg8::Gemm g{(const pg8::bf16_t*)(ws + WS_H), (const pg8::bf16_t*)(ws + WS_W1), T_ALL, 3072, 1024}; pg8::StaticOrder S; S.init(T_ALL, 3072, G, (int)blockIdx.x);
            float* ck = OUTP() + (size_t)T_ALL * 1024 + (size_t)j * 256 * 1024;
            static_assert(WS_K == WS_Q + (72u << 20) && WS_V == WS_Q + (152u << 20), "EpiQKV buffer spacing");
            pg8::EpiQKV E{ws + WS_Q, ck, (const float*)(ws + WS_ROPE), (const float*)(ws + WS_ROPE) + 1024};
            #ifndef NO_G3
pg8::gemm_phase<pg8::EpiQKV, pg8::StaticOrder, true, true>((PG8_LAS unsigned char*)lds, g, S, E);
#ifdef PROBE_G1
            pg8::gemm_phase<pg8::EpiQKV, pg8::StaticOrder, true, true>((PG8_LAS unsigned char*)lds, g, S, E);
#endif
#endif
        }
        GSYNC();
        if (!isffn) {
            if (ishy) { phase_conv3(j, lds); GSYNC();
#ifndef NO_FFT
#ifdef PROBE_FFT
phase_fft(j, lds, true); GSYNC();
#endif
phase_fft(j, lds, false);
#endif
 GSYNC(); phase_gate(j, lds); GSYNC(); }
            else {
#ifndef NO_ATT
phase_attention(lds);
#ifdef PROBE_ATT
 GSYNC(); phase_attention(lds);
#endif
#endif
 GSYNC(); phase_combine(layer); GSYNC(); }
        }
        {
            const pg8::bf16_t* A = isffn ? (const pg8::bf16_t*)(ws + WS_ACT) : (const pg8::bf16_t*)(ws + WS_H);
            const pg8::bf16_t* B = isffn ? (const pg8::bf16_t*)(ws + WS_WDN) : (const pg8::bf16_t*)(ws + WS_W2);
            const int K = isffn ? DFF : 1024;
            pg8::Gemm g{A, B, T_ALL, 1024, K}; pg8::StaticOrder S; S.init(T_ALL, 1024, G, (int)blockIdx.x);
            const float* bias = (!isffn && ishy) ? INP(I_HBOUT) + (size_t)j * 1024 : nullptr;
            pg8::EpiRes E{(pg8::bf16_t*)(ws + WS_X16), INP(I_XP), INP(I_XS), mods_l + (isffn ? 5 : 2) * 1024, bias, s == 0 ? 1 : 0};
            #ifndef NO_G4
pg8::gemm_phase<pg8::EpiRes, pg8::StaticOrder, true, true>((PG8_LAS unsigned char*)lds, g, S, E);
#endif
        }
        if (isffn && layer < 3 && G == 256 && blockIdx.x >= 64) {
            phase_convert_weights(layer + 1, lds, 1, (int)blockIdx.x - 64, 192);
            if ((layer + 1) & 1) phase_filter((layer + 1) >> 1, lds, (int)blockIdx.x - 64, 192);
        }
        GSYNC();
    }
#ifdef PROBE_SYNC
#pragma unroll 1
    for (int q = 0; q < 40; ++q) GSYNC();
#endif
    phase_final_norm();
}

extern "C" void kernel_launch(void* const* d_in, const int* in_sizes, int n_in, void* d_out, int out_size, void* d_ws, size_t ws_size, hipStream_t stream) {
    static int grid_blocks = 0;
    if (grid_blocks == 0) {
        if (n_in != 31 || ws_size < WS_END) { fprintf(stderr, "kernel_launch: unexpected n_in %d or ws_size %zu (need %zu)\n", n_in, ws_size, (size_t)WS_END); grid_blocks = -1; return; }
        int dev = 0, cus = 0, per_cu = 0;
        hipGetDevice(&dev);
        hipDeviceGetAttribute(&cus, hipDeviceAttributeMultiprocessorCount, dev);
        if (hipFuncSetAttribute((const void*)fwd_megakernel, hipFuncAttributeMaxDynamicSharedMemorySize, LDS_BYTES) != hipSuccess) { fprintf(stderr, "kernel_launch: hipFuncSetAttribute failed\n"); grid_blocks = -1; return; }
        if (hipOccupancyMaxActiveBlocksPerMultiprocessor(&per_cu, (const void*)fwd_megakernel, 512, LDS_BYTES) != hipSuccess || per_cu < 1) { fprintf(stderr, "kernel_launch: occupancy query says %d\n", per_cu); per_cu = 1; }
        (void)hipGetLastError();
        grid_blocks = cus * 1;
        fprintf(stderr, "kernel_launch: cus %d per_cu %d grid %d ws %zu\n", cus, per_cu, grid_blocks, ws_size);
    }
    if (grid_blocks < 0) return;
    Params p{};
    for (int i = 0; i < 31; ++i) p.in[i] = (const float*)d_in[i];
    p.out = (float*)d_out; p.ws = (unsigned char*)d_ws;
    void* args[] = {&p};
    hipError_t e = hipLaunchCooperativeKernel((const void*)fwd_megakernel, dim3(grid_blocks), dim3(512), args, LDS_BYTES, stream);
    if (e != hipSuccess) fprintf(stderr, "kernel_launch: cooperative launch failed: %s (grid %d)\n", hipGetErrorString(e), grid_blocks);
}
```

```cpp
#include <hip/hip_runtime.h>
#include <hip/hip_bf16.h>
#include <hip/hip_cooperative_groups.h>
#include <cstdio>
#include <cstdint>
namespace cg = cooperative_groups;
__device__ __forceinline__ int tidx() { int t = threadIdx.x; asm volatile("" : "+v"(t)); return t; }

namespace pg8 {
#define PG8_LAS __attribute__((address_space(3)))
typedef unsigned short bf16_t;
typedef short bf16x8 __attribute__((ext_vector_type(8)));
typedef float f32x4 __attribute__((ext_vector_type(4)));
typedef unsigned u32x4 __attribute__((ext_vector_type(4)));
constexpr int BM = 256, BK = 64, HALF = 128, HTB = HALF * BK * 2  , STAGE_BYTES = 8 * HTB, NXCD = 8, WGM = 8;

__host__ __device__ __forceinline__ int lds_byte(int r, int c) { const int st = (r >> 4) * 2 + (c >> 5), rr = r & 15, cc = c & 31, ob = rr * 64 + cc * 2; return st * 1024 + (ob ^ (((ob >> 9) & 1) << 5)); }
__host__ __device__ __forceinline__ void stage_rc(int b, int& R, int& C) { const int st = b / 1024, sb = b % 1024, swz = sb ^ (((sb >> 9) & 1) << 5); R = (st >> 1) * 16 + swz / 64; C = (st & 1) * 32 + (swz % 64) / 2; }
__host__ __device__ __forceinline__ int perm32(int rho) { const int n = rho >> 4, i = rho & 15; return 8 * (i >> 2) + 4 * n + (i & 3); }

struct Unit { int pm, pn, kt0, nkt, split; };
struct Gemm { const bf16_t* A; const bf16_t* Bt; int M, N, K; };

struct StaticOrder {
    int nM, nN, nwg, G, c;
    __host__ __device__ void init(int M, int N, int G_, int c_) { nM = M / BM; nN = N / BM; nwg = nM * nN; G = G_; c = c_; }
    __host__ __device__ bool next(int i, Unit& u) const {
        const long L = (long)i * G + c; if (L >= nwg) return false;
        int wgid = (int)L; { const int q = nwg / NXCD, r = nwg % NXCD, xcd = wgid % NXCD, off = wgid / NXCD; wgid = (xcd < r ? xcd * (q + 1) : r * (q + 1) + (xcd - r) * q) + off; }
        const int nig = WGM * nN, gid = wgid / nig, fm = gid * WGM, gsz = (nM - fm) < WGM ? (nM - fm) : WGM;
        u.pm = fm + ((wgid % nig) % gsz); u.pn = (wgid % nig) / gsz; u.kt0 = 0; u.nkt = 0; u.split = -1; return true;
    }
    __device__ __forceinline__ void a_ready(const Unit&) const {}
    __device__ __forceinline__ void done(const Unit&) const {}
};

__device__ __forceinline__ unsigned cvt_pk_bf16(float lo, float hi) { unsigned r; asm volatile("v_cvt_pk_bf16_f32 %0, %1, %2" : "=v"(r) : "v"(lo), "v"(hi)); return r; }

struct SplitOrder {
    int G, c, nt;
    __host__ __device__ void init(int K, int G_, int c_) { nt = K / BK; G = G_; c = c_; }
    __host__ __device__ bool next(int i, Unit& u) const {
        const int L = i * G + c; if (L >= 512 + 256) return false;
        int tile;
        if (L < 512) { tile = (L % NXCD) * 64 + L / NXCD; u.kt0 = 0; u.nkt = 0; u.split = -1; }
        else { const int r = L - 512, s = r & 3; tile = 512 + (r >> 2);
            const int q = (nt / 4) & ~1, rp = (nt - 4 * q) / 2;
            u.split = s; u.nkt = q + (s < rp ? 2 : 0); u.kt0 = s * q + 2 * (s < rp ? s : rp); }
        const int gid = tile >> 5, w = tile & 31;
        u.pm = gid * 8 + (w & 7); u.pn = w >> 3; return true;
    }
    __device__ __forceinline__ void a_ready(const Unit&) const {}
    __device__ __forceinline__ void done(const Unit&) const {}
};
typedef unsigned u32x2 __attribute__((ext_vector_type(2)));
struct EpiBf16 {
    static constexpr bool PERM = true, AFTER_DRAIN = false;
    bf16_t* O; int ldc; const float* bias;
    __device__ __forceinline__ void operator()(const f32x4 (&acc)[2][2][4][2], const Unit& u, int wr, int wc, int fr, int fq) const {
        const int row0 = u.pm * BM + wr * 64 + fr; const int col0 = u.pn * BM + wc * 32 + 8 * fq;
        f32x4 bv[2][2];
#pragma unroll
        for (int bj = 0; bj < 2; ++bj)
#pragma unroll
            for (int n = 0; n < 2; ++n) bv[bj][n] = *(const f32x4*)(bias + col0 + bj * HALF + 4 * n);
#pragma unroll
        for (int ai = 0; ai < 2; ++ai)
#pragma unroll
            for (int m = 0; m < 4; ++m) { bf16_t* rowp = O + (size_t)(row0 + ai * HALF + m * 16) * ldc + col0;
#pragma unroll
                for (int bj = 0; bj < 2; ++bj) { const f32x4 v0 = acc[ai][bj][m][0] + bv[bj][0], v1 = acc[ai][bj][m][1] + bv[bj][1];
                    u32x4 w; w.x = cvt_pk_bf16(v0[0], v0[1]); w.y = cvt_pk_bf16(v0[2], v0[3]); w.z = cvt_pk_bf16(v1[0], v1[1]); w.w = cvt_pk_bf16(v1[2], v1[3]);
                    *(u32x4*)(rowp + bj * HALF) = w; } }
    }
};
__device__ __forceinline__ float silu_f(float x) { return x * __builtin_amdgcn_rcpf(1.0f + __builtin_amdgcn_exp2f(-1.4426950408889634f * x)); }
struct EpiSwiglu {
    static constexpr bool PERM = true, AFTER_DRAIN = false;
    bf16_t* O;
    __device__ __forceinline__ void operator()(const f32x4 (&acc)[2][2][4][2], const Unit& u, int wr, int wc, int fr, int fq) const {
        const int row0 = u.pm * BM + wr * 64 + fr; const int col0 = u.pn * HALF + wc * 32 + 8 * fq;
#pragma unroll
        for (int ai = 0; ai < 2; ++ai)
#pragma unroll
            for (int m = 0; m < 4; ++m) { bf16_t* rowp = O + (size_t)(row0 + ai * HALF + m * 16) * 2816 + col0;
                const f32x4 g0 = acc[ai][0][m][0], g1 = acc[ai][0][m][1], u0 = acc[ai][1][m][0], u1 = acc[ai][1][m][1];
                float r[8];
#pragma unroll
                for (int i = 0; i < 4; ++i) { r[i] = silu_f(g0[i]) * u0[i]; r[4 + i] = silu_f(g1[i]) * u1[i]; }
                u32x4 w; w.x = cvt_pk_bf16(r[0], r[1]); w.y = cvt_pk_bf16(r[2], r[3]); w.z = cvt_pk_bf16(r[4], r[5]); w.w = cvt_pk_bf16(r[6], r[7]);
                *(u32x4*)rowp = w; }
    }
};
struct EpiRes {
    static constexpr bool PERM = true, AFTER_DRAIN = false;
    bf16_t* X16; const float* xs_ctx; const float* xs_smp; const float* gate; const float* bias; int first;
    __device__ __forceinline__ void operator()(const f32x4 (&acc)[2][2][4][2], const Unit& u, int wr, int wc, int fr, int fq) const {
        const int g = u.pm >> 4; const float* gp = gate + (size_t)g * 6144;
        const int col0 = u.pn * BM + wc * 32 + 8 * fq;
#pragma unroll
        for (int bj = 0; bj < 2; ++bj) {
            const int co = col0 + bj * HALF;
            const f32x4 gv0 = *(const f32x4*)(gp + co), gv1 = *(const f32x4*)(gp + co + 4);
            const f32x4 bv0 = bias ? *(const f32x4*)(bias + co) : (f32x4){0.f, 0.f, 0.f, 0.f}, bv1 = bias ? *(const f32x4*)(bias + co + 4) : (f32x4){0.f, 0.f, 0.f, 0.f};
#pragma unroll
            for (int ai = 0; ai < 2; ++ai)
#pragma unroll
                for (int m = 0; m < 4; ++m) { const int row = u.pm * BM + ai * HALF + wr * 64 + m * 16 + fr;
                    bf16_t* xo = X16 + (size_t)row * 1024 + co;
                    f32x4 o0, o1;
                    if (first) { const float* xs = (g == 0 ? xs_ctx + (size_t)row * 1024 : xs_smp + (size_t)(row - 4096) * 1024) + co; o0 = __builtin_nontemporal_load((const f32x4*)xs); o1 = __builtin_nontemporal_load((const f32x4*)(xs + 4)); }
                    else { const u32x4 w = __builtin_nontemporal_load((const u32x4*)xo); o0 = (f32x4){__builtin_bit_cast(float, w.x << 16), __builtin_bit_cast(float, w.x & 0xffff0000u), __builtin_bit_cast(float, w.y << 16), __builtin_bit_cast(float, w.y & 0xffff0000u)};
                        o1 = (f32x4){__builtin_bit_cast(float, w.z << 16), __builtin_bit_cast(float, w.z & 0xffff0000u), __builtin_bit_cast(float, w.w << 16), __builtin_bit_cast(float, w.w & 0xffff0000u)}; }
                    const f32x4 n0 = o0 + gv0 * (acc[ai][bj][m][0] + bv0), n1 = o1 + gv1 * (acc[ai][bj][m][1] + bv1);
                    u32x4 wn; wn.x = cvt_pk_bf16(n0[0], n0[1]); wn.y = cvt_pk_bf16(n0[2], n0[3]); wn.z = cvt_pk_bf16(n1[0], n1[1]); wn.w = cvt_pk_bf16(n1[2], n1[3]);
                    *(u32x4*)xo = wn; }
        }
    }
};
constexpr float QSCALE = 0.125f * 1.4426950408889634f;
struct EpiQKV {
    static constexpr bool PERM = false, AFTER_DRAIN = false;
    unsigned char* qbase; float* ck; const float* rcos; const float* rsin;
    __device__ __forceinline__ void operator()(const f32x4 (&acc)[2][2][4][2], const Unit& u, int wr, int wc, int fr, int fq) const {
        const int part = u.pn >> 2, colt = (u.pn & 3) * BM, g = u.pm >> 4;
        const int col0 = colt + wc * 32 + 4 * fq;
        const bool rope = (g > 0) && (part < 2);
        const int axis = wc & 1;
        bf16_t* const dstb = (bf16_t*)(qbase + (size_t)part * (72u << 20) + (size_t)(part >> 1) * (8u << 20));
        float* const cdst = ck + (size_t)(part >> 1) * ((size_t)16 * 2 * 256 * 1024);
#pragma unroll
        for (int ai = 0; ai < 2; ++ai)
#pragma unroll
            for (int m = 0; m < 4; ++m) {
                const int row = u.pm * BM + ai * HALF + wr * 64 + m * 16 + fr;
                const int t = row & 4095;
                f32x4 c4 = (f32x4){1.f, 1.f, 1.f, 1.f}, s4 = (f32x4){0.f, 0.f, 0.f, 0.f};
                if (rope) { const int posi = axis ? (t & 63) : (t >> 6); c4 = *(const f32x4*)(rcos + posi * 16 + 4 * fq); s4 = *(const f32x4*)(rsin + posi * 16 + 4 * fq); }
                size_t drow = (size_t)row;
                if (part != 0 && g > 0) drow = (size_t)(4096 + (g - 1) * 4608 + 512 + t);
                bf16_t* base = dstb + drow * 1024 + col0;
#pragma unroll
                for (int bj = 0; bj < 2; ++bj) {
                    const f32x4 v0 = acc[ai][bj][m][0], v1 = acc[ai][bj][m][1];
                    const bool odd = fq & 1; const int cofs = bj * HALF + (odd ? 12 : 0);
                    if (g == 0 && part != 0) { float* o = cdst + (size_t)(row >> 8) * (2 * 256 * 1024) + (size_t)(row & 255) * 1024 + col0 + cofs;
                        const f32x4 snd = odd ? v0 : v1; f32x4 rcv; rcv[0] = __shfl_xor(snd[0], 16); rcv[1] = __shfl_xor(snd[1], 16); rcv[2] = __shfl_xor(snd[2], 16); rcv[3] = __shfl_xor(snd[3], 16);
                        __builtin_nontemporal_store(odd ? rcv : v0, (f32x4*)o); __builtin_nontemporal_store(odd ? v1 : rcv, (f32x4*)(o + 4)); }
                    f32x4 o0 = v0 * c4 - v1 * s4, o1 = v1 * c4 + v0 * s4;
                    if (part == 0) { o0 = o0 * QSCALE; o1 = o1 * QSCALE; }
                    u32x2 w0, w1; w0.x = cvt_pk_bf16(o0[0], o0[1]); w0.y = cvt_pk_bf16(o0[2], o0[3]); w1.x = cvt_pk_bf16(o1[0], o1[1]); w1.y = cvt_pk_bf16(o1[2], o1[3]);
                    const u32x2 snd = odd ? w0 : w1; u32x2 rcv; rcv.x = __shfl_xor(snd.x, 16); rcv.y = __shfl_xor(snd.y, 16);
                    u32x4 wo; if (odd) { wo.x = rcv.x; wo.y = rcv.y; wo.z = w1.x; wo.w = w1.y; } else { wo.x = w0.x; wo.y = w0.y; wo.z = rcv.x; wo.w = rcv.y; }
                    *(u32x4*)(base + cofs) = wo; }
            }
    }
};

template <class Epi, class Sched, bool ALIGN_EPI = false, bool SP2 = false>
__device__ __forceinline__ void gemm_phase(PG8_LAS unsigned char* lds, const Gemm g, const Sched& S, const Epi& E) {
    const int tid = tidx(), wid = __builtin_amdgcn_readfirstlane(tid >> 6), lane = tid & 63, wr = wid >> 2, wc = wid & 3, fr = lane & 15, fq = lane >> 4;
    const int K = g.K, nt = K / BK;
    unsigned voffA[2], voffB[2];
#pragma unroll
    for (int i = 0; i < 2; ++i) { int R, C; stage_rc(tid * 16 + i * 8192, R, C); const int Rb = Epi::PERM ? ((R & ~31) + perm32(R & 31)) : R;
        voffA[i] = (unsigned)(R * K + C) * 2u; voffB[i] = (unsigned)(Rb * K + C) * 2u; }
    const size_t kstep = (size_t)(BK * 2);
    const size_t hstep = (size_t)HALF * K * 2;
    const size_t tstep = 2 * hstep;
    const unsigned ldsw = (unsigned)wid * 1024u;
    const int aoff = lds_byte(wr * 64 + fr, fq * 8), boff = lds_byte(wc * 32 + fr, fq * 8);
#define PG8_SA(b, h) (((b) * 2 + (h)) * HTB)
#define PG8_SB(b, h) ((4 + (b) * 2 + (h)) * HTB)
#define PG8_STAGE(bufoff, gbase, voff) do { _Pragma("unroll") for (int _i = 0; _i < 2; ++_i) \
        __builtin_amdgcn_global_load_lds((const unsigned*)((const char*)(gbase) + (voff)[_i]), (PG8_LAS unsigned*)(lds + (bufoff) + ldsw + _i * 8192), 16, 0, 0); } while (0)
#define PG8_LDA(dst, b, h) do { _Pragma("unroll") for (int m = 0; m < 4; ++m) _Pragma("unroll") for (int k = 0; k < 2; ++k) dst[m][k] = *(const PG8_LAS bf16x8*)(lds + PG8_SA(b, h) + aoff + m * 2048 + k * 1024); } while (0)
#define PG8_LDB(dst, b, h) do { _Pragma("unroll") for (int n = 0; n < 2; ++n) _Pragma("unroll") for (int k = 0; k < 2; ++k) dst[n][k] = *(const PG8_LAS bf16x8*)(lds + PG8_SB(b, h) + boff + n * 2048 + k * 1024); } while (0)
#define PG8_MMA(ai, bj, At, Bt) do { __builtin_amdgcn_s_setprio(1); _Pragma("unroll") for (int m = 0; m < 4; ++m) _Pragma("unroll") for (int n = 0; n < 2; ++n) _Pragma("unroll") for (int k = 0; k < 2; ++k) \
        acc[ai][bj][m][n] = __builtin_amdgcn_mfma_f32_16x16x32_bf16(Bt[n][k], At[m][k], acc[ai][bj][m][n], 0, 0, 0); __builtin_amdgcn_s_setprio(0); } while (0)
#define PG8_WAIT_V(n) asm volatile("s_waitcnt vmcnt(" #n ")" ::: "memory")
#define PG8_WAIT_L(n) asm volatile("s_waitcnt lgkmcnt(" #n ")" ::: "memory")
#define PG8_BAR __builtin_amdgcn_s_barrier()
#define PG8_SCHED __builtin_amdgcn_sched_barrier(0)
    Unit cur, nxt; int ui = 0;
    if (!S.next(0, cur)) return;
    f32x4 acc[2][2][4][2];
#pragma unroll
    for (int a = 0; a < 2; ++a)
#pragma unroll
        for (int b = 0; b < 2; ++b)
#pragma unroll
            for (int m = 0; m < 4; ++m)
#pragma unroll
                for (int n = 0; n < 2; ++n) acc[a][b][m][n] = (f32x4){0.f, 0.f, 0.f, 0.f};
    bf16x8 At[4][2], B0[2][2], B1[2][2];
    const char* cA = (const char*)g.A + (size_t)cur.pm * tstep + (size_t)cur.kt0 * kstep; const char* cB = (const char*)g.Bt + (size_t)cur.pn * tstep + (size_t)cur.kt0 * kstep;
    S.a_ready(cur);
    if constexpr (SP2) {
        PG8_STAGE(PG8_SB(0, 0), cB, voffB); PG8_STAGE(PG8_SB(0, 1), cB + hstep, voffB); PG8_STAGE(PG8_SA(0, 0), cA, voffA); PG8_STAGE(PG8_SA(0, 1), cA + hstep, voffA);
        if (wr == 1) PG8_BAR;
        PG8_WAIT_V(2); PG8_BAR;
        PG8_STAGE(PG8_SB(1, 0), cB + kstep, voffB); PG8_STAGE(PG8_SA(1, 0), cA + kstep, voffA); PG8_STAGE(PG8_SB(1, 1), cB + hstep + kstep, voffB);
        PG8_WAIT_V(6); PG8_BAR;
    } else {
        PG8_STAGE(PG8_SB(0, 0), cB, voffB); PG8_STAGE(PG8_SA(0, 0), cA, voffA); PG8_STAGE(PG8_SB(0, 1), cB + hstep, voffB); PG8_STAGE(PG8_SA(0, 1), cA + hstep, voffA);
        if (wr == 1) PG8_BAR;
        PG8_WAIT_V(4); PG8_BAR;
        PG8_STAGE(PG8_SB(1, 0), cB + kstep, voffB); PG8_STAGE(PG8_SA(1, 0), cA + kstep, voffA); PG8_STAGE(PG8_SB(1, 1), cB + hstep + kstep, voffB);
        PG8_WAIT_V(6); PG8_BAR;
    }
    for (;;) {
        const bool has_next = S.next(ui + 1, nxt);
        const char* nA = has_next ? (const char*)g.A + (size_t)nxt.pm * tstep + (size_t)nxt.kt0 * kstep : cA; const char* nB = has_next ? (const char*)g.Bt + (size_t)nxt.pn * tstep + (size_t)nxt.kt0 * kstep : cB;
        const int unt = cur.nkt ? cur.nkt : nt;
        for (int t = 0; t < unt; t += 2) {
            const bool last = (t == unt - 2);
            const char* a1 = cA + (size_t)(t + 1) * kstep;
            const char* a2 = last ? nA : cA + (size_t)(t + 2) * kstep; const char* b2 = last ? nB : cB + (size_t)(t + 2) * kstep;
            const char* a3 = a2 + kstep; const char* b3 = b2 + kstep;
            if (last && has_next) S.a_ready(nxt);
            if constexpr (SP2) {
            PG8_LDB(B0, 0, 0); PG8_LDB(B1, 0, 1); PG8_SCHED; PG8_LDA(At, 0, 0); PG8_STAGE(PG8_SA(1, 1), a1 + hstep, voffA);
            PG8_WAIT_V(8); PG8_WAIT_L(0); PG8_BAR; PG8_MMA(0, 0, At, B0); PG8_MMA(0, 1, At, B1); PG8_BAR; PG8_SCHED;
            PG8_LDA(At, 0, 1); PG8_STAGE(PG8_SB(0, 0), b2, voffB); PG8_STAGE(PG8_SB(0, 1), b2 + hstep, voffB); PG8_STAGE(PG8_SA(0, 0), a2, voffA);
            PG8_WAIT_V(8); PG8_WAIT_L(0); PG8_BAR; PG8_MMA(1, 0, At, B0); PG8_MMA(1, 1, At, B1); PG8_BAR; PG8_SCHED;
            PG8_LDB(B0, 1, 0); PG8_LDB(B1, 1, 1); PG8_SCHED; PG8_LDA(At, 1, 0); PG8_STAGE(PG8_SA(0, 1), a2 + hstep, voffA);
            PG8_WAIT_V(8); PG8_WAIT_L(0); PG8_BAR; PG8_MMA(0, 0, At, B0); PG8_MMA(0, 1, At, B1); PG8_BAR; PG8_SCHED;
            PG8_LDA(At, 1, 1); PG8_STAGE(PG8_SB(1, 0), b3, voffB); PG8_STAGE(PG8_SB(1, 1), b3 + hstep, voffB); PG8_STAGE(PG8_SA(1, 0), a3, voffA);
            PG8_WAIT_V(8); PG8_WAIT_L(0); PG8_BAR; PG8_MMA(1, 0, At, B0); PG8_MMA(1, 1, At, B1); PG8_BAR; PG8_SCHED;
            } else {
            PG8_LDB(B0, 0, 0); PG8_SCHED; PG8_LDA(At, 0, 0); PG8_STAGE(PG8_SA(1, 1), a1 + hstep, voffA);
            PG8_WAIT_L(8); PG8_BAR; PG8_WAIT_L(0); PG8_MMA(0, 0, At, B0); PG8_BAR; PG8_SCHED;
            PG8_LDB(B1, 0, 1); PG8_STAGE(PG8_SB(0, 0), b2, voffB);
            PG8_BAR; PG8_WAIT_L(0); PG8_MMA(0, 1, At, B1); PG8_BAR;
            PG8_LDA(At, 0, 1); PG8_STAGE(PG8_SA(0, 0), a2, voffA);
            PG8_BAR; PG8_WAIT_L(0); PG8_MMA(1, 0, At, B0); PG8_BAR; PG8_SCHED;
            PG8_STAGE(PG8_SB(0, 1), b2 + hstep, voffB);
            PG8_WAIT_V(6); PG8_BAR; PG8_MMA(1, 1, At, B1); PG8_BAR;
            PG8_LDB(B0, 1, 0); PG8_SCHED; PG8_LDA(At, 1, 0); PG8_STAGE(PG8_SA(0, 1), a2 + hstep, voffA);
            PG8_WAIT_L(8); PG8_BAR; PG8_WAIT_L(0); PG8_MMA(0, 0, At, B0); PG8_BAR; PG8_SCHED;
            PG8_LDB(B1, 1, 1); PG8_STAGE(PG8_SB(1, 0), b3, voffB);
            PG8_BAR; PG8_WAIT_L(0); PG8_MMA(0, 1, At, B1); PG8_BAR;
            PG8_LDA(At, 1, 1); PG8_STAGE(PG8_SA(1, 0), a3, voffA);
            PG8_BAR; PG8_WAIT_L(0); PG8_MMA(1, 0, At, B0); PG8_BAR; PG8_SCHED;
            PG8_STAGE(PG8_SB(1, 1), b3 + hstep, voffB);
            PG8_WAIT_V(6); PG8_BAR; PG8_MMA(1, 1, At, B1); PG8_BAR;
            }
        }
        if constexpr (ALIGN_EPI) { if (wr == 0) PG8_BAR; }
        if constexpr (!Epi::AFTER_DRAIN) { E(acc, cur, wr, wc, fr, fq); S.done(cur); }
        if (!has_next) break;
#pragma unroll
        for (int a = 0; a < 2; ++a)
#pragma unroll
            for (int b = 0; b < 2; ++b)
#pragma unroll
                for (int m = 0; m < 4; ++m)
#pragma unroll
                    for (int n = 0; n < 2; ++n) acc[a][b][m][n] = (f32x4){0.f, 0.f, 0.f, 0.f};
        cur = nxt; cA = nA; cB = nB; ++ui;
        if constexpr (ALIGN_EPI) { if (wr == 1) PG8_BAR; }
    }
    PG8_WAIT_V(0);
    if constexpr (!ALIGN_EPI) { if (wr == 0) PG8_BAR; }
    PG8_BAR;
    if constexpr (Epi::AFTER_DRAIN) { E.fused(acc, cur, wr, wc, fr, fq, lds, wid, lane); S.done(cur); }
#undef PG8_SA
#undef PG8_SB
#undef PG8_STAGE
#undef PG8_LDA
#undef PG8_LDB
#undef PG8_MMA
#undef PG8_WAIT_V
#undef PG8_WAIT_L
#undef PG8_BAR
#undef PG8_SCHED
}
}
namespace attn {
using bf16 = __hip_bfloat16;
constexpr int NW = 8, QBLK = 32, KVBLK = 64, LD = 1024;
constexpr float SCALE = 0.125f;
constexpr float THR = 8.f;
constexpr size_t SHM_V = KVBLK * 128 * 2, SHM_K = KVBLK * 128 * 2, SHM_ATTN = 2 * SHM_V + 2 * SHM_K + NW * 64 * 4;
using bf16x8 = __attribute__((ext_vector_type(8))) short;
using s16x4  = __attribute__((ext_vector_type(4))) short;
using f32x16 = __attribute__((ext_vector_type(16))) float;
using u32x4  = __attribute__((ext_vector_type(4))) unsigned;
#define KSWZ(row, colB) ((row) * 256 + ((colB) ^ (((row) & 7) << 4)))
#define SBAR() __builtin_amdgcn_sched_barrier(0)
__device__ __forceinline__ int crow(int r, int hi) { return (r & 3) + 8 * (r >> 2) + 4 * hi; }
__device__ __forceinline__ unsigned cvtpk(float lo, float hi) { unsigned r; asm volatile("v_cvt_pk_bf16_f32 %0, %1, %2" : "=v"(r) : "v"(lo), "v"(hi)); return r; }
__device__ __forceinline__ bf16x8 ld8(const bf16* p) { return *reinterpret_cast<const bf16x8*>(p); }

constexpr float THRL = THR * 1.4426950408889634f;
template <bool FIRST> __device__ __forceinline__ void partialSM(f32x16& p0, f32x16& p1, float& m_reg, float& alpha) {
  float pmax = fmaxf(fmaxf(p0[0], p0[1]), p1[0]);
#pragma unroll
  for (int r = 2; r < 16; r += 2) pmax = fmaxf(fmaxf(pmax, p0[r]), p0[r + 1]);
#pragma unroll
  for (int r = 1; r < 15; r += 2) pmax = fmaxf(fmaxf(pmax, p1[r]), p1[r + 1]);
  pmax = fmaxf(pmax, p1[15]);
  { auto rr = __builtin_amdgcn_permlane32_swap(__float_as_uint(pmax), __float_as_uint(pmax), false, false);
    pmax = fmaxf(__uint_as_float(rr[0]), __uint_as_float(rr[1])); }
  alpha = 1.f;
  if (FIRST || !__builtin_expect(__all(pmax <= THRL), 1)) {
    const float dl = FIRST ? pmax : fmaxf(pmax, 0.f);
    m_reg += dl; if (!FIRST) alpha = __builtin_amdgcn_exp2f(-dl);
#pragma unroll
    for (int r = 0; r < 16; ++r) { p0[r] -= dl; p1[r] -= dl; }
  }
#pragma unroll
  for (int r = 0; r < 16; ++r) p0[r] = __builtin_amdgcn_exp2f(p0[r]);
}
__device__ __forceinline__ void finishSM(f32x16& p0, f32x16& p1, float alpha, float& l_reg, bf16x8& pa0, bf16x8& pa1, bf16x8& pa2, bf16x8& pa3) {
#pragma unroll
  for (int r = 0; r < 16; ++r) p1[r] = __builtin_amdgcn_exp2f(p1[r]);
  float ps;
  { const f32x16 t = p0 + p1; typedef float f32x8v __attribute__((ext_vector_type(8))); typedef float f32x4v __attribute__((ext_vector_type(4))); typedef float f32x2v __attribute__((ext_vector_type(2)));
    const f32x8v t8 = __builtin_shufflevector(t, t, 0, 1, 2, 3, 4, 5, 6, 7) + __builtin_shufflevector(t, t, 8, 9, 10, 11, 12, 13, 14, 15);
    const f32x4v t4 = __builtin_shufflevector(t8, t8, 0, 1, 2, 3) + __builtin_shufflevector(t8, t8, 4, 5, 6, 7);
    const f32x2v t2 = __builtin_shufflevector(t4, t4, 0, 1) + __builtin_shufflevector(t4, t4, 2, 3); ps = t2.x + t2.y; }
  { auto rr = __builtin_amdgcn_permlane32_swap(__float_as_uint(ps), __float_as_uint(ps), false, false);
    ps = __uint_as_float(rr[0]) + __uint_as_float(rr[1]); }
  l_reg = l_reg * alpha + ps;
#define PK4(P, BASE, OUT) do { unsigned a0 = cvtpk(P[BASE + 0], P[BASE + 1]), a1 = cvtpk(P[BASE + 2], P[BASE + 3]);   \
    unsigned b0 = cvtpk(P[BASE + 4], P[BASE + 5]), b1 = cvtpk(P[BASE + 6], P[BASE + 7]);                              \
    auto r0 = __builtin_amdgcn_permlane32_swap(a0, b0, false, false); auto r1 = __builtin_amdgcn_permlane32_swap(a1, b1, false, false); \
    u32x4 w = {r0[0], r1[0], r0[1], r1[1]}; OUT = *reinterpret_cast<bf16x8*>(&w); } while (0)
  PK4(p0, 0, pa0); PK4(p0, 8, pa1); PK4(p1, 0, pa2); PK4(p1, 8, pa3);
#undef PK4
}
__device__ __forceinline__ void qkt(f32x16& p0, f32x16& p1, const bf16* Ks, const bf16x8* qr, int r32, int hi, float m_ref) {
  { const float nm = -m_ref;
#pragma unroll
    for (int r = 0; r < 16; ++r) { p0[r] = nm; p1[r] = nm; } }
#pragma unroll
  for (int d0 = 0; d0 < 4; ++d0) { int cb = (d0 * 16 + hi * 8) * 2;
    bf16x8 b0 = *reinterpret_cast<const bf16x8*>((const char*)Ks + KSWZ(r32, cb));
    bf16x8 b1 = *reinterpret_cast<const bf16x8*>((const char*)Ks + KSWZ(32 + r32, cb));
    p0 = __builtin_amdgcn_mfma_f32_32x32x16_bf16(b0, qr[d0], p0, 0, 0, 0);
    p1 = __builtin_amdgcn_mfma_f32_32x32x16_bf16(b1, qr[d0], p1, 0, 0, 0); }
}
__device__ __forceinline__ int v_st(int k, int c) { const int kk = (k & ~0xC) | ((k & 4) << 1) | ((k & 8) >> 1); return ((kk >> 3) * 4 + (c >> 5)) * 512 + ((kk & 7) * 32 + (c & 31)) * 2; }
__device__ __forceinline__ int v_rd_base(int lane) { return ((lane & 3) << 3) | (((lane >> 2) & 3) << 6) | (((lane >> 4) & 1) << 5) | (((lane >> 5) & 1) << 8); }
constexpr int v_rd_off(int d0, int ks, int half) { return d0 * 512 + ks * 4096 + half * 2048; }
template <int OFF> __device__ __forceinline__ s16x4 tr_read(int vb) {
  s16x4 r; asm volatile("ds_read_b64_tr_b16 %0, %1 offset:%2" : "=&v"(r) : "v"(vb), "i"(OFF) : "memory"); return r;
}
template <int D0> __device__ __forceinline__ void pv_one(f32x16& od, int vb, bf16x8 pa0, bf16x8 pa1, bf16x8 pa2, bf16x8 pa3) {
  const s16x4 l0 = tr_read<v_rd_off(D0, 0, 0)>(vb), h0 = tr_read<v_rd_off(D0, 0, 1)>(vb), l1 = tr_read<v_rd_off(D0, 1, 0)>(vb), h1 = tr_read<v_rd_off(D0, 1, 1)>(vb);
  const s16x4 l2 = tr_read<v_rd_off(D0, 2, 0)>(vb), h2 = tr_read<v_rd_off(D0, 2, 1)>(vb), l3 = tr_read<v_rd_off(D0, 3, 0)>(vb), h3 = tr_read<v_rd_off(D0, 3, 1)>(vb);
  asm volatile("s_waitcnt lgkmcnt(0)" ::: "memory"); SBAR();
#define PK(L, H) (bf16x8){L[0], L[1], L[2], L[3], H[0], H[1], H[2], H[3]}
  od = __builtin_amdgcn_mfma_f32_32x32x16_bf16(pa0, PK(l0, h0), od, 0, 0, 0);
  od = __builtin_amdgcn_mfma_f32_32x32x16_bf16(pa1, PK(l1, h1), od, 0, 0, 0);
  od = __builtin_amdgcn_mfma_f32_32x32x16_bf16(pa2, PK(l2, h2), od, 0, 0, 0);
  od = __builtin_amdgcn_mfma_f32_32x32x16_bf16(pa3, PK(l3, h3), od, 0, 0, 0);
#undef PK
}
__device__ __forceinline__ void pv_d0(f32x16* o, int vb, bf16x8 pa0, bf16x8 pa1, bf16x8 pa2, bf16x8 pa3) {
  pv_one<0>(o[0], vb, pa0, pa1, pa2, pa3); pv_one<1>(o[1], vb, pa0, pa1, pa2, pa3); pv_one<2>(o[2], vb, pa0, pa1, pa2, pa3); pv_one<3>(o[3], vb, pa0, pa1, pa2, pa3);
}
struct AUnit { const bf16* Q; const bf16* K; const bf16* V; bf16* O; int seq; };
template <class Units> __device__ __forceinline__ void attn_run(const Units& U, char* lds) {
  const int tid = tidx(), wid = tid >> 6, lane = tid & 63, r32 = lane & 31, hi = lane >> 5;
  bf16* V_lds = (bf16*)lds; bf16* K_lds = (bf16*)(lds + 2 * SHM_V);
  float* ws = (float*)(lds + 2 * SHM_V + 2 * SHM_K) + wid * 64; float* li_l = ws; float* al_l = ws + 32;
  const int sr = tid >> 4, sc = (tid & 15) * 8, vst0 = v_st(sr, sc), vst1 = v_st(32 + sr, sc);
  const int kr = tid >> 3, kc = (tid & 7) * 8, kst = KSWZ(kr, kc * 2);
  const int vb0 = (int)(uintptr_t)V_lds + v_rd_base(lane);
  struct { bf16x8 vs0, vs1, ks0; } sr_[2];
  bf16x8 qr[4];
  constexpr int SE = 0, SO = 1;
  const unsigned voff0 = (unsigned)(sr * LD + sc), voff1 = (unsigned)((32 + sr) * LD + sc), koff = (unsigned)(kr * LD + kc);
#define SLOADU(i, UN, k0) do { const bf16* vt_ = (UN).V + (size_t)(k0) * LD; const bf16* kt_ = (UN).K + (size_t)(k0) * LD; \
    sr_[i].vs0 = ld8(vt_ + voff0); sr_[i].vs1 = ld8(vt_ + voff1); sr_[i].ks0 = ld8(kt_ + koff); } while (0)
#define QLOADU(UN) do { const bf16* Qw_ = (UN).Q + (long)(wid * QBLK + r32) * LD + hi * 8; \
    _Pragma("unroll") for (int d0 = 0; d0 < 4; ++d0) qr[d0] = __builtin_nontemporal_load(reinterpret_cast<const bf16x8*>(Qw_ + d0 * 16)); } while (0)
#define SLOAD(i, k0) SLOADU(i, cur, k0)
#define SWRITE(b, i) do { *(bf16x8*)((char*)V_lds + (b) * SHM_V + vst0) = sr_[i].vs0;          \
    *(bf16x8*)((char*)V_lds + (b) * SHM_V + vst1) = sr_[i].vs1;               \
    *(bf16x8*)((char*)K_lds + (b) * SHM_K + kst) = sr_[i].ks0; } while (0)
#define SWAIT() asm volatile("s_waitcnt vmcnt(3)" ::: "memory")
#define RESC(a) do { if (__any((a) < 1.f)) { if (hi == 0) al_l[r32] = (a); asm volatile("s_waitcnt lgkmcnt(0)" ::: "memory"); \
    _Pragma("unroll") for (int d = 0; d < 4; ++d) _Pragma("unroll") for (int r = 0; r < 16; ++r) o[d][r] *= al_l[crow(r, hi)]; } } while (0)
  { AUnit f; if (U.get(0, f)) { SLOADU(SE, f, 0); } }
#pragma unroll 1
  for (int ui = 0; ; ++ui) {
    AUnit cur; if (!U.get(ui, cur)) break;
    QLOADU(cur);
    float m_reg = 0.f, l_reg = 0; f32x16 o[4] = {};
    f32x16 pA0, pA1, pB0, pB1; float alA, alB; bf16x8 pa0, pa1, pa2, pa3; const int NT = cur.seq / KVBLK;
    SWRITE(0, SE); __syncthreads();
    qkt(pA0, pA1, K_lds, qr, r32, hi, 0.f); partialSM<true>(pA0, pA1, m_reg, alA);
    SLOAD(SO, KVBLK); if (2 < NT) SLOAD(SE, 2 * KVBLK);
    SWAIT(); SWRITE(1, SO); __syncthreads();
    for (int j = 1; j + 1 < NT; j += 2) {
      SBAR(); qkt(pB0, pB1, (bf16*)((char*)K_lds + SHM_K), qr, r32, hi, m_reg);
      finishSM(pA0, pA1, alA, l_reg, pa0, pa1, pa2, pa3); SBAR();
      SLOAD(SO, (j + 2) * KVBLK); SBAR();
      pv_d0(o, vb0, pa0, pa1, pa2, pa3); partialSM<false>(pB0, pB1, m_reg, alB);
      __syncthreads(); SWAIT(); SWRITE(0, SE);
      RESC(alB); __syncthreads();
      SBAR(); qkt(pA0, pA1, K_lds, qr, r32, hi, m_reg);
      finishSM(pB0, pB1, alB, l_reg, pa0, pa1, pa2, pa3); SBAR();
      if (j + 3 < NT) SLOAD(SE, (j + 3) * KVBLK); SBAR();
      pv_d0(o, vb0 + (int)SHM_V, pa0, pa1, pa2, pa3); partialSM<false>(pA0, pA1, m_reg, alA);
      __syncthreads(); SWAIT(); SWRITE(1, SO);
      RESC(alA); __syncthreads();
    }
    SBAR(); qkt(pB0, pB1, (bf16*)((char*)K_lds + SHM_K), qr, r32, hi, m_reg);
    finishSM(pA0, pA1, alA, l_reg, pa0, pa1, pa2, pa3); SBAR();
    { AUnit nxt; if (U.get(ui + 1, nxt)) { SLOADU(SE, nxt, 0); } } SBAR();
    pv_d0(o, vb0, pa0, pa1, pa2, pa3); partialSM<false>(pB0, pB1, m_reg, alB);
    __syncthreads(); RESC(alB);
    finishSM(pB0, pB1, alB, l_reg, pa0, pa1, pa2, pa3); SBAR();
    pv_d0(o, vb0 + (int)SHM_V, pa0, pa1, pa2, pa3);
    if (hi == 0) li_l[r32] = l_reg; asm volatile("s_waitcnt lgkmcnt(0)" ::: "memory");
    float rli[16];
#pragma unroll
    for (int r = 0; r < 16; ++r) rli[r] = __builtin_amdgcn_rcpf(li_l[crow(r, hi)]);
    bf16* Ow = cur.O + (long)(wid * QBLK) * LD;
#pragma unroll
    for (int r = 0; r < 16; ++r) { int orow = crow(r, hi);
#pragma unroll
      for (int d0 = 0; d0 < 4; ++d0) Ow[(long)orow * LD + d0 * 32 + r32] = __float2bfloat16(o[d0][r] * rli[r]); }
    __syncthreads();
  }
#undef SLOADU
#undef QLOADU
#undef SLOAD
#undef SWRITE
#undef SWAIT
#undef RESC
}
#undef KSWZ
#undef SBAR
}

#define FFT_HD __device__ __forceinline__
#ifndef FFT_HD
#define FFT_HD __host__ __device__ __forceinline__
#endif
typedef float cf __attribute__((ext_vector_type(2)));
FFT_HD cf cmul(cf a, cf b) { const cf t = {-a.y, a.x}; return a * b.x + t * b.y; }
FFT_HD cf cmulc(cf a, cf b) { const cf t = {a.y, -a.x}; return a * b.x + t * b.y; }
FFT_HD int fpad(int i) { return i + (i >> 4); }
FFT_HD cf twid(float rev) {
#if defined(__HIP_DEVICE_COMPILE__)
  return cf{__builtin_amdgcn_cosf(rev), -__builtin_amdgcn_sinf(rev)};
#else
  return cf{cosf(6.283185307179586f * rev), -sinf(6.283185307179586f * rev)};
#endif
}
FFT_HD cf rot16(cf d, int k) {
  const float s = 0.70710678119f, c1 = 0.92387953251f, s1 = 0.38268343236f;
  switch (k & 15) {
    case 0: return d;
    case 4: return cf{d.y, -d.x};
    case 8: return cf{-d.x, -d.y};
    case 12: return cf{-d.y, d.x};
    case 2: return cf{(d.x + d.y) * s, (d.y - d.x) * s};
    case 6: return cf{(d.y - d.x) * s, -(d.x + d.y) * s};
    case 10: return cf{-(d.x + d.y) * s, (d.x - d.y) * s};
    case 14: return cf{(d.x - d.y) * s, (d.x + d.y) * s};
    case 1: return cmul(d, cf{c1, -s1});
    case 3: return cmul(d, cf{s1, -c1});
    case 5: return cmul(d, cf{-s1, -c1});
    case 7: return cmul(d, cf{-c1, -s1});
    case 9: return cmul(d, cf{-c1, s1});
    case 11: return cmul(d, cf{-s1, c1});
    case 13: return cmul(d, cf{s1, c1});
    default: return cmul(d, cf{c1, s1});
  }
}
template <int LOG_R, bool UNIT, bool ZHALF> FFT_HD void dif_group(cf (&v)[1 << LOG_R], cf w0) {
  constexpr int R = 1 << LOG_R;
  cf wk = w0;
#pragma unroll
  for (int k = 0; k < LOG_R; ++k) {
    const int half = R >> (k + 1);
#pragma unroll
    for (int m = 0; m < R; ++m) {
      if ((m & half) == 0) {
        const int mm = m & (half - 1);
        cf d;
        if (ZHALF && k == 0) { d = v[m]; }
        else { const cf a = v[m], b = v[m + half]; d = a - b; v[m] = a + b; }
        if (!UNIT) d = cmul(d, wk);
        v[m + half] = rot16(d, (mm << k) * (16 / R));
      }
    }
    if (!UNIT) wk = cmul(wk, wk);
  }
}
template <int LOG_R, bool UNIT, bool LOWONLY> FFT_HD void dit_group(cf (&v)[1 << LOG_R], cf w0) {
  constexpr int R = 1 << LOG_R;
  cf wp[LOG_R];
  wp[0] = w0;
#pragma unroll
  for (int k = 1; k < LOG_R; ++k) wp[k] = cmul(wp[k - 1], wp[k - 1]);
#pragma unroll
  for (int k = LOG_R - 1; k >= 0; --k) {
    const int half = R >> (k + 1);
#pragma unroll
    for (int m = 0; m < R; ++m) {
      if ((m & half) == 0) {
        const int mm = m & (half - 1);
        cf B = rot16(v[m + half], 16 - (mm << k) * (16 / R));
        if (!UNIT) B = cmulc(B, wp[k]);
        const cf A = v[m];
        v[m] = A + B;
        if (!(LOWONLY && k == 0)) v[m + half] = A - B;
      }
    }
  }
}
template <int S> FFT_HD constexpr int goff(int m) { return S >= 16 ? m * S + m * (S / 16) : m * S + ((m * S) >> 4); }
template <bool INV, int LC, class P> FFT_HD void fft_pass8(P a, int NTOT, int tid, int nthr) {
  constexpr int S = LC >> 3;
  static_assert(S >= 8, "fft_pass8: S >= 8");
  for (int g = tid; g < (NTOT >> 3); g += nthr) {
    const int blk = g / S, j = g - blk * S, pb = fpad(blk * LC + j);
    cf v[8];
#pragma unroll
    for (int m = 0; m < 8; ++m) v[m] = a[pb + goff<S>(m)];
    const cf w0 = twid((float)j * (1.0f / (float)LC));
    if (INV) dit_group<3, false, false>(v, w0); else dif_group<3, false, false>(v, w0);
#pragma unroll
    for (int m = 0; m < 8; ++m) a[pb + goff<S>(m)] = v[m];
  }
}
constexpr int DM = 1024, T_ALL = 36864, NGRP = 9, DFF = 2816;
constexpr size_t MiB = 1u << 20;
constexpr size_t WS_MODS = 64 * 1024;
constexpr size_t WS_ROPE = 1008 * 1024;
constexpr size_t WS_HDN2 = 1 * MiB;
constexpr size_t WS_W1 = 4 * MiB, WS_W2 = 10 * MiB, WS_WGU = 12 * MiB, WS_WDN = 23 * MiB;
constexpr size_t WS_H = 29 * MiB;
constexpr size_t WS_BIG = 101 * MiB;
constexpr size_t WS_Q = WS_BIG, WS_K = WS_BIG + 72 * MiB, WS_V = WS_K + 80 * MiB, WS_O1 = WS_V + 80 * MiB;
constexpr size_t WS_U = WS_BIG, WS_VXT = WS_BIG + 216 * MiB;
constexpr size_t WS_ACT = WS_BIG;
constexpr size_t WS_X16 = WS_BIG + 304 * MiB;
constexpr size_t WS_FILT = WS_X16 + 72 * MiB;
constexpr size_t WS_END = WS_FILT + 34 * MiB;
static_assert(WS_END <= 512 * MiB && WS_O1 + 72 * MiB <= WS_X16 && WS_VXT + 72 * MiB <= WS_X16, "ws map");
constexpr int LDS_BYTES = 147456;

typedef unsigned short bf16_t;
typedef float f32x4 __attribute__((ext_vector_type(4)));
typedef unsigned u32x4 __attribute__((ext_vector_type(4)));
typedef unsigned u32x2 __attribute__((ext_vector_type(2)));

struct Params { const float* in[31]; float* out; unsigned char* ws; };
typedef const __attribute__((address_space(4))) unsigned char* kargp_t;
__device__ __forceinline__ unsigned long long karg_u64(int i) {
    const volatile __attribute__((address_space(4))) unsigned* k = (const volatile __attribute__((address_space(4))) unsigned*)__builtin_amdgcn_kernarg_segment_ptr();
    const unsigned lo = __builtin_amdgcn_readfirstlane(k[2 * i]), hi = __builtin_amdgcn_readfirstlane(k[2 * i + 1]);
    return ((unsigned long long)hi << 32) | lo; }
#define GAS1 __attribute__((address_space(1)))
__device__ __forceinline__ const float* INP(int i) { return (const float*)(const GAS1 float*)karg_u64(i); }
__device__ __forceinline__ float* OUTP() { return (float*)(GAS1 float*)karg_u64(31); }
__device__ __forceinline__ unsigned char* WSP() { return (unsigned char*)(GAS1 unsigned char*)karg_u64(32); }
enum { I_XP = 0, I_XS, I_CK, I_CV, I_C, I_CCTX, I_ADAW, I_ADAB, I_N1G, I_N2G, I_WQKV, I_LAM, I_SUBG, I_WO, I_HWIN, I_HBIN, I_HCW, I_HCB,
       I_FW1, I_FB1, I_FW2, I_FB2, I_FW3, I_FB3, I_FFREQ, I_SKIP, I_HWOUT, I_HBOUT, I_WGU, I_WDN, I_FING };

__device__ __forceinline__ unsigned f2bf(float f) { unsigned u = __builtin_bit_cast(unsigned, f); return (u + 0x7fffu + ((u >> 16) & 1u)) >> 16; }
__device__ __forceinline__ unsigned pk2(float lo, float hi) { return f2bf(lo) | (f2bf(hi) << 16); }
__device__ __forceinline__ float bf2f(unsigned short b) { return __builtin_bit_cast(float, (unsigned)b << 16); }
__device__ __forceinline__ float bflo(unsigned w) { return __builtin_bit_cast(float, w << 16); }
__device__ __forceinline__ float bfhi(unsigned w) { return __builtin_bit_cast(float, w & 0xffff0000u); }
template <class T> __device__ __forceinline__ T ldnt(const T* p) { return __builtin_nontemporal_load(p); }
__device__ __forceinline__ float wave_sum(float v) {
#pragma unroll
    for (int o = 1; o < 64; o <<= 1) v += __shfl_xor(v, o);
    return v;
}

__device__ __forceinline__ void transpose_item(const float* W, int K, int N, bf16_t* WT, float* scr, int item, int lane, int mode) {
    const int nblk = N / 32, kb = item / nblk, nb = item % nblk, k0 = 64 * kb, n0 = 32 * nb;
    int n0p = n0;
    if (mode == 1) { const int part = n0 >= DFF ? 1 : 0, jj = n0 - part * DFF; n0p = 256 * (jj >> 7) + 128 * part + (jj & 127); }
#pragma unroll 8
    for (int i = 0; i < 32; ++i) { const int kk = 2 * i + (lane >> 5); scr[kk * 33 + (lane & 31)] = ldnt(W + (size_t)(k0 + kk) * N + n0 + (lane & 31)); }
    __builtin_amdgcn_s_waitcnt(0); asm volatile("" ::: "memory");
    const int c = lane & 7;
#pragma unroll
    for (int j = 0; j < 4; ++j) { const int n = (lane >> 3) + 8 * j; const float* s = scr + (8 * c) * 33 + n;
        u32x4 o; o.x = pk2(s[0 * 33], s[1 * 33]); o.y = pk2(s[2 * 33], s[3 * 33]); o.z = pk2(s[4 * 33], s[5 * 33]); o.w = pk2(s[6 * 33], s[7 * 33]);
        *(u32x4*)(WT + (size_t)(n0p + n) * K + k0 + 8 * c) = o; }
    __builtin_amdgcn_s_waitcnt(0); asm volatile("" ::: "memory");
}
__device__ __forceinline__ void phase_convert_weights(int layer, unsigned char* lds, int which, int bidx, int nblk) {
    const int wid = tidx() >> 6, lane = tidx() & 63;
    float* scr = (float*)(lds + wid * 16384);
    const int gw = bidx * 8 + wid, NGW = nblk * 8;
    const int j = layer >> 1; const bool hy = layer & 1;
    const float* w1 = hy ? INP(I_HWIN) + (size_t)j * 1024 * 3072 : INP(I_WQKV) + (size_t)j * 1024 * 3072;
    const float* w2 = hy ? INP(I_HWOUT) + (size_t)j * 1024 * 1024 : INP(I_WO) + (size_t)j * 1024 * 1024;
    const float* wgu = INP(I_WGU) + (size_t)layer * 1024 * 5632;
    const float* wdn = INP(I_WDN) + (size_t)layer * 2816 * 1024;
    constexpr int I1 = 16 * 96, I2 = 16 * 32, I3 = 16 * 176, I4 = 44 * 32;
    const int lo = which == 2 ? I1 + I2 + I3 : 0, hi = which == 1 ? I1 + I2 + I3 : I1 + I2 + I3 + I4;
    for (int it = lo + gw; it < hi; it += NGW) {
        int r = it;
        if (r < I1) { transpose_item(w1, 1024, 3072, (bf16_t*)(WSP() + WS_W1), scr, r, lane, 0); continue; } r -= I1;
        if (r < I2) { transpose_item(w2, 1024, 1024, (bf16_t*)(WSP() + WS_W2), scr, r, lane, 0); continue; } r -= I2;
        if (r < I3) { transpose_item(wgu, 1024, 5632, (bf16_t*)(WSP() + WS_WGU), scr, r, lane, 1); continue; } r -= I3;
        transpose_item(wdn, 2816, 1024, (bf16_t*)(WSP() + WS_WDN), scr, r, lane, 0);
    }
}

__device__ __forceinline__ void phase0(unsigned char* lds) {
    const int tid = tidx(), wid = tid >> 6, lane = tid & 63;
    {
        float* sc = (float*)lds;
        float* red = (float*)(lds + 9 * 1024 * 4);
        if ((int)blockIdx.x < 192) {
            for (int e = tid; e < 9 * 1024; e += 512) { const int g = e >> 10, k = e & 1023; const float x = g == 0 ? INP(I_CCTX)[k] : INP(I_C)[(g - 1) * 1024 + k];
                sc[e] = x / (1.0f + expf(-x)); }
            __syncthreads();
            for (int it = blockIdx.x; it < 192; it += gridDim.x) {
                const int i = it / 48, chunk = it % 48, cg4 = tid & 31, kl = tid >> 5;
                f32x4 acc[9];
#pragma unroll
                for (int g = 0; g < 9; ++g) acc[g] = (f32x4){0.f, 0.f, 0.f, 0.f};
                const float* wp = INP(I_ADAW) + (size_t)i * 1024 * 6144 + chunk * 128 + cg4 * 4;
                for (int k = kl; k < 1024; k += 16) { const f32x4 w = ldnt((const f32x4*)(wp + (size_t)k * 6144));
#pragma unroll
                    for (int g = 0; g < 9; ++g) acc[g] += w * sc[g * 1024 + k]; }
#pragma unroll
                for (int g = 0; g < 9; ++g) *(f32x4*)(red + (kl * 9 + g) * 128 + cg4 * 4) = acc[g];
                __syncthreads();
                for (int e = tid; e < 9 * 128; e += 512) { const int g = e >> 7, col = e & 127; float s = INP(I_ADAB)[i * 6144 + chunk * 128 + col];
#pragma unroll
                    for (int q = 0; q < 16; ++q) s += red[(q * 9 + g) * 128 + col];
                    ((float*)(WSP() + WS_MODS))[((size_t)i * 9 + g) * 6144 + chunk * 128 + col] = s; }
                __syncthreads();
            }
        }
    }
    {
        const int gw = blockIdx.x * 8 + wid, NGW = gridDim.x * 8;
        for (int idx = gw; idx < 2 * 4352; idx += NGW) {
            const int jh = idx / 4352, r = idx % 4352; const int L = r < 4096 ? 4096 : 256, pos = r < 4096 ? r : r - 4096;
            const float fpos = (float)pos;
            const float tt = fpos / (float)(L - 1);
            const float w = 6.283185307179586f * fpos / (float)L;
            float z;
            { const int bi = lane == 0 ? 0 : ((lane - 1) & 15); const float band = 1e-4f + (float)bi * ((15.0f - 1e-4f) / 15.0f); const float a = w * band;
              z = lane == 0 ? tt : (lane <= 16 ? cosf(a) : -sinf(a)); }
            const float* w1 = INP(I_FW1) + (size_t)jh * 33 * 64; const float* w2 = INP(I_FW2) + (size_t)jh * 64 * 64;
            const float fr = INP(I_FFREQ)[jh * 64 + lane];
            float a1 = INP(I_FB1)[jh * 64 + lane];
            for (int f = 0; f < 33; ++f) a1 += __shfl(z, f) * w1[f * 64 + lane];
            const float h1 = sinf(fr * a1);
            float a2 = INP(I_FB2)[jh * 64 + lane];
            for (int k = 0; k < 64; ++k) a2 += __shfl(h1, k) * w2[k * 64 + lane];
            ((float*)(WSP() + WS_HDN2))[(size_t)idx * 64 + lane] = sinf(fr * a2);
        }
    }
    if (blockIdx.x == gridDim.x - 1) {
        for (int e = tid; e < 1024; e += 512) { const int posi = e >> 4, f = e & 15; const float inv = powf(10000.0f, -(float)f / 16.0f); const float ang = (float)posi * inv;
            ((float*)(WSP() + WS_ROPE))[e] = cosf(ang); ((float*)(WSP() + WS_ROPE))[1024 + e] = sinf(ang); }
    }
}

__device__ __forceinline__ void phase_norm(const float* gamma, const float* mods_l, int shift_idx, bool first) {
    const int wid = tidx() >> 6, lane = tidx() & 63;
    const int gw = blockIdx.x * 8 + wid, NGW = gridDim.x * 8;
    bf16_t* H = (bf16_t*)(WSP() + WS_H);
    const float* xc = INP(I_XP); const float* xm = INP(I_XS); const bf16_t* X16 = (const bf16_t*)(WSP() + WS_X16);
    f32x4 gm[4];
#pragma unroll
    for (int j = 0; j < 4; ++j) gm[j] = *(const f32x4*)(gamma + 4 * lane + 256 * j);
    for (int row0 = gw; row0 < T_ALL; row0 += 2 * NGW) {
        f32x4 v[2][4]; float s[2];
#pragma unroll
        for (int q = 0; q < 2; ++q) { const int row = row0 + q * NGW; s[q] = 0.f;
            if (row < T_ALL) {
                if (first) { const f32x4* xr = (const f32x4*)(row < 4096 ? xc + (size_t)row * 1024 : xm + (size_t)(row - 4096) * 1024) + lane;
#pragma unroll
                    for (int j = 0; j < 4; ++j) v[q][j] = ldnt(xr + 64 * j); }
                else { const u32x2* xr = (const u32x2*)(X16 + (size_t)row * 1024) + lane;
#pragma unroll
                    for (int j = 0; j < 4; ++j) { const u32x2 w = ldnt(xr + 64 * j); v[q][j] = (f32x4){bflo(w.x), bfhi(w.x), bflo(w.y), bfhi(w.y)}; } }
#pragma unroll
                for (int j = 0; j < 4; ++j) s[q] += (v[q][j].x * v[q][j].x + v[q][j].y * v[q][j].y) + (v[q][j].z * v[q][j].z + v[q][j].w * v[q][j].w); } }
#pragma unroll
        for (int q = 0; q < 2; ++q) { const int row = row0 + q * NGW;
            if (row < T_ALL) {
                const float* mp = mods_l + (size_t)(row >> 12) * 6144;
                const float rstd = 1.0f / sqrtf(wave_sum(s[q]) * (1.0f / 1024.0f) + 1e-6f);
                u32x2* o = (u32x2*)(H + (size_t)row * 1024) + lane;
#pragma unroll
                for (int j = 0; j < 4; ++j) { const f32x4 sh = *(const f32x4*)(mp + shift_idx * 1024 + 4 * lane + 256 * j), scl = *(const f32x4*)(mp + (shift_idx + 1) * 1024 + 4 * lane + 256 * j);
                    const f32x4 y = v[q][j] * rstd * gm[j] * (scl + 1.0f) + sh;
                    u32x2 w; w.x = pk2(y.x, y.y); w.y = pk2(y.z, y.w); o[64 * j] = w; } } }
    }
}
__device__ __forceinline__ void phase_final_norm() {
    const int wid = tidx() >> 6, lane = tidx() & 63;
    const int gw = blockIdx.x * 8 + wid, NGW = gridDim.x * 8;
    const float* gamma = INP(I_FING); const bf16_t* X16 = (const bf16_t*)(WSP() + WS_X16);
    f32x4 gm[4];
#pragma unroll
    for (int j = 0; j < 4; ++j) gm[j] = *(const f32x4*)(gamma + 4 * lane + 256 * j);
    for (int row = gw; row < T_ALL; row += NGW) {
        const u32x2* xr = (const u32x2*)(X16 + (size_t)row * 1024) + lane;
        f32x4 v[4]; float s = 0.f;
#pragma unroll
        for (int j = 0; j < 4; ++j) { const u32x2 w = xr[64 * j]; v[j] = (f32x4){bflo(w.x), bfhi(w.x), bflo(w.y), bfhi(w.y)}; s += (v[j].x * v[j].x + v[j].y * v[j].y) + (v[j].z * v[j].z + v[j].w * v[j].w); }
        const float rstd = 1.0f / sqrtf(wave_sum(s) * (1.0f / 1024.0f) + 1e-6f);
        f32x4* o = (f32x4*)(OUTP() + (size_t)row * 1024) + lane;
#pragma unroll
        for (int j = 0; j < 4; ++j) __builtin_nontemporal_store(v[j] * rstd * gm[j], o + 64 * j);
    }
}
__device__ __forceinline__ void phase_cache_convert(int j) {
    bf16_t* Kb = (bf16_t*)(WSP() + WS_K); bf16_t* Vb = (bf16_t*)(WSP() + WS_V);
    const size_t n8 = (size_t)8 * 512 * 1024 / 8;
    for (size_t i = (size_t)blockIdx.x * 512 + tidx(); i < 2 * n8; i += (size_t)gridDim.x * 512) {
        const bool isv = i >= n8; const size_t e = (isv ? i - n8 : i) * 8; const int b = (int)(e / (512 * 1024)); const size_t rem = e % (512 * 1024);
        const float* src = (isv ? INP(I_CV) : INP(I_CK)) + ((size_t)(b * 2 + j) * 512 * 1024) + rem;
        const f32x4 a = ldnt((const f32x4*)src), c = ldnt((const f32x4*)(src + 4));
        u32x4 w; w.x = pk2(a.x, a.y); w.y = pk2(a.z, a.w); w.z = pk2(c.x, c.y); w.w = pk2(c.z, c.w);
        *(u32x4*)((isv ? Vb : Kb) + (size_t)(4096 + b * 4608) * 1024 + rem) = w;
    }
}
struct AttnUnits {
    int vcu, G;
    __device__ __forceinline__ bool get(int i, attn::AUnit& u) const {
        const int id = vcu + i * G; if (id >= 2048 + 256) return false;
        int b, h, mp; size_t qrow, krow;
        if (id < 2048) { const int bh = id >> 5, r = id & 31; b = bh >> 3; h = bh & 7; mp = r >> 4; const int qb = r & 15; u.seq = 4608;
            qrow = (size_t)4096 + (size_t)b * 4096 + qb * 256; krow = (size_t)4096 + (size_t)b * 4608; }
        else { const int r = id - 2048; b = r >> 4; h = (r >> 1) & 7; mp = r & 1; u.seq = 256; qrow = (size_t)b * 256; krow = qrow; }
        unsigned char* ws = WSP();
        u.Q = (const attn::bf16*)(ws + WS_Q) + qrow * 1024 + h * 128 + mp * 64; u.K = (const attn::bf16*)(ws + WS_K) + krow * 1024 + h * 128 + mp * 64; u.V = (const attn::bf16*)(ws + WS_V) + krow * 1024 + h * 128;
        u.O = (attn::bf16*)(ws + (mp ? WS_O1 : WS_H)) + qrow * 1024 + h * 128; return true;
    }
};
__device__ __forceinline__ void phase_attention(unsigned char* lds) {
    const int G = gridDim.x, bx = blockIdx.x; const int vcu = (G % 8 == 0) ? (bx % 8) * (G / 8) + bx / 8 : bx;
    AttnUnits U{vcu, G};
    attn::attn_run(U, (char*)lds);
}
__device__ __forceinline__ void phase_combine(int layer) {
    const int wid = tidx() >> 6, lane = tidx() & 63;
    const int gw = blockIdx.x * 8 + wid, NGW = gridDim.x * 8;
    const int j = layer >> 1;
    const float* lp = INP(I_LAM) + (size_t)j * 4 * 64;
    const float s1 = wave_sum(lp[lane] * lp[64 + lane]), s2 = wave_sum(lp[128 + lane] * lp[192 + lane]);
    const float lam_init = 0.8f - 0.6f * expf(-0.3f * (float)layer);
    const float lam = expf(s1) - expf(s2) + lam_init;
    const float osc = 1.0f - lam_init;
    bf16_t* O0 = (bf16_t*)(WSP() + WS_H); const bf16_t* O1 = (const bf16_t*)(WSP() + WS_O1);
    float gsub[16];
#pragma unroll
    for (int e = 0; e < 16; ++e) gsub[e] = INP(I_SUBG)[j * 128 + (lane & 7) * 16 + e] * osc;
    for (int row = gw; row < T_ALL; row += NGW) {
        u32x4* a = (u32x4*)(O0 + (size_t)row * 1024) + lane * 2; const u32x4* c = (const u32x4*)(O1 + (size_t)row * 1024) + lane * 2;
        const u32x4 a0 = ldnt((const u32x4*)a), a1 = ldnt((const u32x4*)a + 1), c0 = ldnt(c), c1 = ldnt(c + 1);
        float v[16];
#pragma unroll
        for (int q = 0; q < 4; ++q) { v[2 * q] = bflo(a0[q]) - lam * bflo(c0[q]); v[2 * q + 1] = bfhi(a0[q]) - lam * bfhi(c0[q]);
            v[8 + 2 * q] = bflo(a1[q]) - lam * bflo(c1[q]); v[8 + 2 * q + 1] = bfhi(a1[q]) - lam * bfhi(c1[q]); }
        float s = 0.f;
#pragma unroll
        for (int e = 0; e < 16; ++e) s += v[e] * v[e];
        s += __shfl_xor(s, 1); s += __shfl_xor(s, 2); s += __shfl_xor(s, 4);
        const float rstd = 1.0f / sqrtf(s * (1.0f / 128.0f) + 1e-5f);
        u32x4 w0, w1;
#pragma unroll
        for (int q = 0; q < 4; ++q) { w0[q] = pk2(v[2 * q] * rstd * gsub[2 * q], v[2 * q + 1] * rstd * gsub[2 * q + 1]);
            w1[q] = pk2(v[8 + 2 * q] * rstd * gsub[8 + 2 * q], v[8 + 2 * q + 1] * rstd * gsub[8 + 2 * q + 1]); }
        a[0] = w0; a[1] = w1;
    }
}
__device__ __forceinline__ size_t vxt_index(int row, int c) {
    return row < 4096 ? ((size_t)((row >> 8) * 1024 + c) * 256 + (row & 255)) : ((size_t)4096 * 1024 + ((size_t)(((row - 4096) >> 12) * 1024 + c) * 4096) + (row & 4095));
}
__device__ __forceinline__ void unpack8(const u32x4 w, float* f) {
#pragma unroll
    for (int q = 0; q < 4; ++q) { f[2 * q] = bflo(w[q]); f[2 * q + 1] = bfhi(w[q]); }
}
#define LDSBAR() do { asm volatile("s_waitcnt lgkmcnt(0)" ::: "memory"); __builtin_amdgcn_s_barrier(); asm volatile("" ::: "memory"); } while (0)
struct Conv3Regs { u32x4 uc[2][2], um[2][2], un[2][2]; };
__device__ __forceinline__ void conv3_load(Conv3Regs& R, const bf16_t* U, int it, int tl, int c8) {
    const int tt = it >> 3, ct = it & 7; const int row = tt * 64 + tl;
    const int L = row < 4096 ? 256 : 4096; const int ts = row & (L - 1);
    const bool hasp = ts > 0, hasn = ts < L - 1;
#pragma unroll
    for (int hf = 0; hf < 2; ++hf)
#pragma unroll
        for (int pq = 0; pq < 2; ++pq) {
            const bf16_t* up = U + (size_t)row * 3072 + (pq + 1) * 1024 + ct * 128 + hf * 64 + c8;
            R.uc[hf][pq] = ldnt((const u32x4*)up);
            R.um[hf][pq] = hasp ? ldnt((const u32x4*)(up - 3072)) : (u32x4){0u, 0u, 0u, 0u};
            R.un[hf][pq] = hasn ? ldnt((const u32x4*)(up + 3072)) : (u32x4){0u, 0u, 0u, 0u};
        }
}
__device__ __forceinline__ void phase_conv3(int jh, unsigned char* lds) {
    const int tid = tidx();
    const bf16_t* U = (const bf16_t*)(WSP() + WS_U); bf16_t* VXT = (bf16_t*)(WSP() + WS_VXT);
    float* tile = (float*)lds;
    const float* cw = INP(I_HCW) + (size_t)jh * 3 * 3072; const float* cb = INP(I_HCB) + (size_t)jh * 3072;
    const int tl = tid >> 3, c8 = (tid & 7) * 8;
    const int NTL = 576 * 8, G = gridDim.x;
    Conv3Regs nx;
    if ((int)blockIdx.x < NTL) conv3_load(nx, U, blockIdx.x, tl, c8);
    for (int it = blockIdx.x; it < NTL; it += G) {
        const int tt = it >> 3, ct = it & 7;
        const Conv3Regs cu = nx;
        if (it + G < NTL) conv3_load(nx, U, it + G, tl, c8);
#pragma unroll
        for (int hf = 0; hf < 2; ++hf) {
            const int c0 = ct * 128 + hf * 64 + c8;
            float res[2][8];
#pragma unroll
            for (int pq = 0; pq < 2; ++pq) {
                const int col = (pq + 1) * 1024 + c0;
                float fm[8], fc[8], fn[8]; unpack8(cu.um[hf][pq], fm); unpack8(cu.uc[hf][pq], fc); unpack8(cu.un[hf][pq], fn);
#pragma unroll
                for (int e = 0; e < 8; ++e) res[pq][e] = fm[e] * cw[col + e] + fc[e] * cw[3072 + col + e] + fn[e] * cw[6144 + col + e] + cb[col + e];
            }
#pragma unroll
            for (int e = 0; e < 8; ++e) tile[(hf * 64 + c8 + e) * 65 + tl] = res[1][e] * res[0][e];
        }
        LDSBAR();
#pragma unroll
        for (int hf = 0; hf < 2; ++hf) { const int cl = hf * 64 + (tid >> 3), t8 = (tid & 7) * 8; const int r0 = tt * 64 + t8, c = ct * 128 + cl;
          f32x4 a, b; a.x = tile[cl * 65 + t8]; a.y = tile[cl * 65 + t8 + 1]; a.z = tile[cl * 65 + t8 + 2]; a.w = tile[cl * 65 + t8 + 3];
          b.x = tile[cl * 65 + t8 + 4]; b.y = tile[cl * 65 + t8 + 5]; b.z = tile[cl * 65 + t8 + 6]; b.w = tile[cl * 65 + t8 + 7];
          u32x4 w; w.x = pk2(a.x, a.y); w.y = pk2(a.z, a.w); w.z = pk2(b.x, b.y); w.w = pk2(b.z, b.w); *(u32x4*)(VXT + vxt_index(r0, c)) = w; }
        LDSBAR();
    }
}
struct GateRegs { u32x4 y[2], uc[2], um[2], un[2]; };
__device__ __forceinline__ void gate_load(GateRegs& R, const bf16_t* VXT, const bf16_t* U, int it, int tid) {
    const int tt = it >> 3, ct = it & 7;
    const int tl = tid >> 3, c8 = (tid & 7) * 8; const int row = tt * 64 + tl;
    const int L = row < 4096 ? 256 : 4096; const int ts = row & (L - 1);
    const bool hasp = ts > 0, hasn = ts < L - 1;
#pragma unroll
    for (int hf = 0; hf < 2; ++hf) { const int cl = hf * 64 + (tid >> 3), t8 = (tid & 7) * 8; const int r0 = tt * 64 + t8, c = ct * 128 + cl;
        R.y[hf] = ldnt((const u32x4*)(VXT + vxt_index(r0, c))); }
#pragma unroll
    for (int hf = 0; hf < 2; ++hf) { const bf16_t* up = U + (size_t)row * 3072 + ct * 128 + hf * 64 + c8;
        R.uc[hf] = ldnt((const u32x4*)up); R.um[hf] = hasp ? ldnt((const u32x4*)(up - 3072)) : (u32x4){0u, 0u, 0u, 0u}; R.un[hf] = hasn ? ldnt((const u32x4*)(up + 3072)) : (u32x4){0u, 0u, 0u, 0u}; }
}
__device__ __forceinline__ void phase_gate(int jh, unsigned char* lds) {
    const int tid = tidx();
    bf16_t* Z = (bf16_t*)(WSP() + WS_H); const bf16_t* VXT = (const bf16_t*)(WSP() + WS_VXT); const bf16_t* U = (const bf16_t*)(WSP() + WS_U);
    const float* cw = INP(I_HCW) + (size_t)jh * 3 * 3072; const float* cb = INP(I_HCB) + (size_t)jh * 3072;
    float* tile = (float*)lds;
    const int NTL = 576 * 8, G = gridDim.x;
    GateRegs nx;
    if ((int)blockIdx.x < NTL) gate_load(nx, VXT, U, blockIdx.x, tid);
    for (int it = blockIdx.x; it < NTL; it += G) {
        const int tt = it >> 3, ct = it & 7;
        const int tl = tid >> 3, c8 = (tid & 7) * 8; const int row = tt * 64 + tl;
        const GateRegs cu = nx;
        if (it + G < NTL) gate_load(nx, VXT, U, it + G, tid);
#pragma unroll
        for (int hf = 0; hf < 2; ++hf) { const int cl = hf * 64 + (tid >> 3), t8 = (tid & 7) * 8; const u32x4 w = cu.y[hf];
          tile[(t8 + 0) * 129 + cl] = bflo(w.x); tile[(t8 + 1) * 129 + cl] = bfhi(w.x); tile[(t8 + 2) * 129 + cl] = bflo(w.y); tile[(t8 + 3) * 129 + cl] = bfhi(w.y);
          tile[(t8 + 4) * 129 + cl] = bflo(w.z); tile[(t8 + 5) * 129 + cl] = bfhi(w.z); tile[(t8 + 6) * 129 + cl] = bflo(w.w); tile[(t8 + 7) * 129 + cl] = bfhi(w.w); }
        LDSBAR();
#pragma unroll
        for (int hf = 0; hf < 2; ++hf) { const int cc = hf * 64 + c8, col = ct * 128 + cc;
          float fm[8], fc[8], fn[8]; unpack8(cu.um[hf], fm); unpack8(cu.uc[hf], fc); unpack8(cu.un[hf], fn);
          float r[8];
#pragma unroll
          for (int e = 0; e < 8; ++e) { const float x0 = fm[e] * cw[col + e] + fc[e] * cw[3072 + col + e] + fn[e] * cw[6144 + col + e] + cb[col + e]; r[e] = x0 * tile[tl * 129 + cc + e]; }
          u32x4 w; w.x = pk2(r[0], r[1]); w.y = pk2(r[2], r[3]); w.z = pk2(r[4], r[5]); w.w = pk2(r[6], r[7]); *(u32x4*)(Z + (size_t)row * 1024 + col) = w; }
        LDSBAR();
    }
}
__device__ __forceinline__ void phase_filter(int jh, unsigned char* lds, int bidx, int nblk) {
    const int tid = tidx(), lx = tid & 63, cgp = tid >> 6;
    float* hs = (float*)lds;
    float* w3s = (float*)(lds + 64 * 65 * 4);
    const float* tab = (const float*)(WSP() + WS_HDN2) + (size_t)jh * 4352 * 64;
    const float* w3 = INP(I_FW3) + (size_t)jh * 64 * 2048; const float* b3 = INP(I_FB3) + jh * 2048;
    float* hT = (float*)(WSP() + WS_FILT);
    __syncthreads();
    for (int it = bidx; it < 68 * 8; it += nblk) {
        const int lt = it >> 3, ctile = it & 7; const int l0 = lt * 64, col0 = ctile * 256;
        for (int e = tid; e < 64 * 64; e += 512) hs[(e >> 6) * 65 + (e & 63)] = tab[(size_t)l0 * 64 + e];
        for (int e = tid; e < 64 * 256; e += 512) w3s[e] = w3[(size_t)(e >> 8) * 2048 + col0 + (e & 255)];
        __syncthreads();
        float acc[32];
#pragma unroll
        for (int q = 0; q < 32; ++q) acc[q] = 0.f;
#pragma unroll 4
        for (int k = 0; k < 64; ++k) { const float hv = hs[lx * 65 + k]; const f32x4* wr = (const f32x4*)(w3s + k * 256 + cgp * 32);
#pragma unroll
            for (int q = 0; q < 8; ++q) { const f32x4 w = wr[q]; acc[4 * q] += hv * w.x; acc[4 * q + 1] += hv * w.y; acc[4 * q + 2] += hv * w.z; acc[4 * q + 3] += hv * w.w; } }
        const int r = l0 + lx; const int L = r < 4096 ? 4096 : 256, pos = r < 4096 ? r : r - 4096;
        const float tl = (float)pos / (float)(L - 1);
        float* ob = r < 4096 ? hT : hT + (size_t)1024 * 2 * 4096;
#pragma unroll
        for (int q = 0; q < 32; ++q) { const int col = col0 + cgp * 32 + q, dir = col >> 10, c = col & 1023;
            const float delta = fabsf(-3.0701134573253945f + (-15.350567286626973f + 3.0701134573253945f) * ((float)c / 1023.0f));
            ob[(size_t)(c * 2 + dir) * L + pos] = (acc[q] + b3[col]) * expf(-tl * delta); }
        __syncthreads();
    }
}
template <bool INV, int LOG_N> __device__ __forceinline__ void fft_mid(cf* a, int NTOT, int tid) {
    if constexpr (LOG_N == 13) {
        if (!INV) { fft_pass8<false, 1024>(a, NTOT, tid, 512); __syncthreads(); fft_pass8<false, 128>(a, NTOT, tid, 512); __syncthreads(); }
        else { fft_pass8<true, 128>(a, NTOT, tid, 512); __syncthreads(); fft_pass8<true, 1024>(a, NTOT, tid, 512); __syncthreads(); }
    } else { fft_pass8<INV, 64>(a, NTOT, tid, 512); __syncthreads(); }
}
template <int LOG_N>
__device__ __forceinline__ void hyena_fft_unit(int jh, int c, unsigned char* lds, bool dry) {
    constexpr int N = 1 << LOG_N, L = N / 2, LOG_L = LOG_N - 1, LOG_LAST = (LOG_N % 3 == 1) ? 4 : 3, RL = 1 << LOG_LAST, S0 = N / 8;
    constexpr int NAR = (LOG_N == 13) ? 2 : 8, NRND = (LOG_N == 13) ? 2 : 1, NTOT = NAR * N;
    const int tid = tidx();
    cf* a = (cf*)lds;
    float* wl = (float*)(lds + 139264);
    bf16_t* vbase = (bf16_t*)(WSP() + WS_VXT) + (LOG_N == 13 ? (size_t)4096 * 1024 : 0);
    const float* hT = (const float*)(WSP() + WS_FILT) + (LOG_N == 13 ? (size_t)0 : (size_t)1024 * 2 * 4096) + (size_t)c * 2 * L;
    float asum = 0.f;
#pragma unroll 4
    for (int i = tid; i < N; i += 512) {
        const float hv = i < L ? hT[i] : hT[L + (i == L ? 0 : N - i)];
        asum += fabsf(hv);
        a[fpad(i)] = cf{i == L ? 0.f : hv, 0.f};
    }
    asum = wave_sum(asum);
    if ((tid & 63) == 0) wl[136 + (tid >> 6)] = asum;
    __syncthreads();
    float tot = 0.f;
#pragma unroll
    for (int q = 0; q < 8; ++q) tot += wl[136 + q];
    const float fs = 1.0f / ((tot + 1e-6f) * (float)N);
    fft_pass8<false, N>(a, N, tid, 512); __syncthreads();
    fft_mid<false, LOG_N>(a, N, tid);
    cf kreg[RL];
    { const int pb = fpad((tid % (N >> LOG_LAST)) * RL);
#pragma unroll
      for (int e = 0; e < RL; ++e) kreg[e] = a[pb + e];
      dif_group<LOG_LAST, true, false>(kreg, cf{1.f, 0.f}); }
    __syncthreads();
    const float skipc = INP(I_SKIP)[jh * 1024 + c];
#pragma unroll 1
    for (int rd = 0; rd < NRND; ++rd) {
        for (int g = tid; g < NTOT / 8; g += 512) {
            const int arr = g / S0, j = g - arr * S0; const int sq = 2 * (rd * NAR + arr);
            const bf16_t* p0 = vbase + (((size_t)sq * 1024 + c) << LOG_L) + j; const bf16_t* p1 = p0 + ((size_t)1024 << LOG_L);
            cf x[8];
#pragma unroll
            for (int m = 0; m < 4; ++m) x[m] = cf{bf2f(p0[m * S0]), bf2f(p1[m * S0])};
#pragma unroll
            for (int m = 4; m < 8; ++m) x[m] = cf{0.f, 0.f};
            dif_group<3, false, true>(x, twid((float)j * (1.0f / (float)N)));
            const int pb = fpad(arr * N + j);
#pragma unroll
            for (int m = 0; m < 8; ++m) a[pb + goff<S0>(m)] = x[m];
        }
        __syncthreads();
        fft_mid<false, LOG_N>(a, NTOT, tid);
        for (int g = tid; g < (NTOT >> LOG_LAST); g += 512) {
            cf x[RL]; const int pb = fpad(g << LOG_LAST);
#pragma unroll
            for (int e = 0; e < RL; ++e) x[e] = a[pb + e];
            dif_group<LOG_LAST, true, false>(x, cf{1.f, 0.f});
#pragma unroll
            for (int e = 0; e < RL; ++e) x[e] = cmul(x[e], kreg[e]);
            dit_group<LOG_LAST, true, false>(x, cf{1.f, 0.f});
#pragma unroll
            for (int e = 0; e < RL; ++e) a[pb + e] = x[e];
        }
        __syncthreads();
        fft_mid<true, LOG_N>(a, NTOT, tid);
        for (int g = tid; g < NTOT / 8; g += 512) {
            const int arr = g / S0, j = g - arr * S0; const int sq = 2 * (rd * NAR + arr);
            bf16_t* p0 = vbase + (((size_t)sq * 1024 + c) << LOG_L) + j; bf16_t* p1 = p0 + ((size_t)1024 << LOG_L);
            cf x[8]; const int pb = fpad(arr * N + j);
#pragma unroll
            for (int m = 0; m < 8; ++m) x[m] = a[pb + goff<S0>(m)];
            dit_group<3, false, true>(x, twid((float)j * (1.0f / (float)N)));
#pragma unroll
            for (int m = 0; m < 4; ++m) { const float v0 = bf2f(p0[m * S0]), v1 = bf2f(p1[m * S0]); const float y0 = x[m].x * fs + v0 * skipc, y1 = x[m].y * fs + v1 * skipc; if (!dry || y0 == 1.2345e30f) { p0[m * S0] = (bf16_t)f2bf(y0); p1[m * S0] = (bf16_t)f2bf(y1); } }
        }
        __syncthreads();
    }
}
__device__ __forceinline__ void phase_fft(int jh, unsigned char* lds, bool dry) {
    for (int it = blockIdx.x; it < 2048; it += gridDim.x) {
        if (it < 1024) hyena_fft_unit<13>(jh, it, lds, dry); else hyena_fft_unit<9>(jh, it - 1024, lds, dry);
    }
}
#define LAS __attribute__((address_space(3)))
#define XB_TMO      128
#define XB_XCNT(j)  (256  + 64 * (j))
#define XB_XSUB(j)  (1280 + 64 * (j))
#define XB_XGEN(j)  (2304 + 64 * (j))
#define XB_TOP      3328
#define XB_TOPGEN   3392
#define XCD_BAR_WORDS 3456
#define XB_SPIN_CAP (1u << 18)

__device__ __forceinline__ unsigned xb_ld(unsigned* p)              { return __hip_atomic_load(p, __ATOMIC_RELAXED, __HIP_MEMORY_SCOPE_AGENT); }
__device__ __forceinline__ unsigned xb_add(unsigned* p, unsigned v) { return __hip_atomic_fetch_add(p, v, __ATOMIC_RELAXED, __HIP_MEMORY_SCOPE_AGENT); }
__device__ __forceinline__ unsigned xb_xcc_id() { return (unsigned)__builtin_amdgcn_s_getreg((3 << 11) | 20) & 0xFu; }
#define XB_SPIN(cond, bar) do { unsigned _sp = 0; while (cond) { __builtin_amdgcn_s_sleep(1); \
    if ((++_sp & 255u) == 0u) { if (xb_ld(&(bar)[XB_TMO])) break; if (_sp > XB_SPIN_CAP) { atomicAdd(&(bar)[XB_TMO], 1u); break; } } } } while (0)

struct XcdBarrier {
    unsigned* bar; unsigned x;
    volatile LAS unsigned* st;
};

__device__ __forceinline__ XcdBarrier xcd_barrier_post(unsigned* bar, volatile LAS unsigned* st) {
    XcdBarrier b; b.bar = bar; b.x = xb_xcc_id(); b.st = st;
    if (threadIdx.x == 0) (void)xb_add(&bar[XB_XCNT(b.x)], 1u);
    return b;
}
__device__ __forceinline__ void xcd_barrier_complete(unsigned* bar, unsigned x, unsigned& nloc, unsigned& nx) {
    const unsigned G = gridDim.x * gridDim.y * gridDim.z;
    unsigned sum, cnt, mine, sp = 0u;
    for (;;) {
        sum = 0u; cnt = 0u; mine = 0u;
#pragma unroll
        for (unsigned j = 0; j < 16; ++j) { const unsigned c = xb_ld(&bar[XB_XCNT(j)]); sum += c; cnt += (c > 0u) ? 1u : 0u; mine = (j == x) ? c : mine; }
        if (sum == G) break;
        __builtin_amdgcn_s_sleep(1);
        if ((++sp & 255u) == 0u) { if (xb_ld(&bar[XB_TMO])) break; if (sp > XB_SPIN_CAP) { atomicAdd(&bar[XB_TMO], 1u); break; } }
    }
    nloc = mine > 0u ? mine : 1u; nx = cnt > 0u ? cnt : 1u;
}

__device__ __forceinline__ void xcd_barrier(const XcdBarrier& b) {
    asm volatile("s_waitcnt vmcnt(0)" ::: "memory");
    __syncthreads();
    if (threadIdx.x == 0) {
        unsigned* bar = b.bar;
        __builtin_amdgcn_s_waitcnt(0);
        unsigned nloc = b.st[0], nx = b.st[1];
        if (nloc == 0u) { xcd_barrier_complete(bar, b.x, nloc, nx); b.st[0] = nloc; b.st[1] = nx; }
        const unsigned old = xb_add(&bar[XB_XSUB(b.x)], 1u);
        const unsigned gen = old / nloc;
        if (old + 1u == (gen + 1u) * nloc) {
            __builtin_amdgcn_fence(__ATOMIC_RELEASE, "agent");
            asm volatile("s_waitcnt vmcnt(0)" ::: "memory");
            const unsigned og = xb_add(&bar[XB_TOP], 1u);
            const unsigned tg = og / nx;
            if (og + 1u == (tg + 1u) * nx) xb_add(&bar[XB_TOPGEN], 1u);
            else XB_SPIN(xb_ld(&bar[XB_TOPGEN]) == tg, bar);
            __builtin_amdgcn_fence(__ATOMIC_ACQUIRE, "agent");
            xb_add(&bar[XB_XGEN(b.x)], 1u);
            asm volatile("s_waitcnt vmcnt(0)" ::: "memory");
        } else {
            XB_SPIN(xb_ld(&bar[XB_XGEN(b.x)]) == gen, bar);
            __builtin_amdgcn_fence(__ATOMIC_ACQUIRE, "agent");
            asm volatile("s_waitcnt vmcnt(0)" ::: "memory");
        }
    }
    __syncthreads();
}
__global__ void __launch_bounds__(512, 2) fwd_megakernel(Params p) {
    extern __shared__ __attribute__((aligned(16))) unsigned char lds[];
    cg::grid_group grid = cg::this_grid();
    const int G = gridDim.x;
    { volatile LAS unsigned* st0 = (volatile LAS unsigned*)((LAS unsigned char*)lds + (LDS_BYTES - 64)); if (tidx() < 2) st0[tidx() & 1] = 0u;
      if (blockIdx.x == 0) { unsigned* bw = (unsigned*)(WSP()); for (int i = tidx(); i < XCD_BAR_WORDS; i += 512) __hip_atomic_store(bw + i, 0u, __ATOMIC_RELAXED, __HIP_MEMORY_SCOPE_AGENT); }
      __syncthreads(); }
#define GSYNC() do { XcdBarrier b_; b_.bar = (unsigned*)(WSP()); b_.x = xb_xcc_id(); b_.st = (volatile LAS unsigned*)((LAS unsigned char*)lds + (LDS_BYTES - 64)); xcd_barrier(b_); } while (0)
#ifndef NO_P0
    phase0(lds);
#ifdef PROBE_P0
    __syncthreads(); phase0(lds); __syncthreads(); phase0(lds);
#endif
#endif
    grid.sync();
    (void)xcd_barrier_post((unsigned*)(WSP()), (volatile LAS unsigned*)((LAS unsigned char*)lds + (LDS_BYTES - 64)));
#pragma unroll 1
    for (int s = 0; s < 8; ++s) {
        const int layer = s >> 1; const bool isffn = s & 1, ishy = layer & 1; const int j = layer >> 1;
        unsigned char* ws = WSP();
        const float* mods_l = (const float*)(ws + WS_MODS) + (size_t)layer * 9 * 6144;
        const bool early = (G == 256) && layer > 0;
        if (!isffn) { phase_convert_weights(layer, lds, early ? 2 : 0, (int)blockIdx.x, G); if (!ishy) phase_cache_convert(j); }
        if (!isffn && ishy && !early) phase_filter(j, lds, (int)blockIdx.x, G);
        phase_norm((isffn ? INP(I_N2G) : INP(I_N1G)) + layer * 1024, mods_l, isffn ? 3 : 0, s == 0);
        GSYNC();
        if (isffn) {
            pg8::Gemm g{(const pg8::bf16_t*)(ws + WS_H), (const pg8::bf16_t*)(ws + WS_WGU), T_ALL, 2 * DFF, 1024}; pg8::StaticOrder S; S.init(T_ALL, 2 * DFF, G, (int)blockIdx.x);
            pg8::EpiSwiglu E{(pg8::bf16_t*)(ws + WS_ACT)};
            #ifndef NO_G1
pg8::gemm_phase<pg8::EpiSwiglu, pg8::StaticOrder, true, true>((PG8_LAS unsigned char*)lds, g, S, E);
#ifdef PROBE_G1
            pg8::gemm_phase<pg8::EpiSwiglu, pg8::StaticOrder, true, true>((PG8_LAS unsigned char*)lds, g, S, E);
#endif
#endif
        } else if (ishy) {
            pg8::Gemm g{(const pg8::bf16_t*)(ws + WS_H), (const pg8::bf16_t*)(ws + WS_W1), T_ALL, 3072, 1024}; pg8::StaticOrder S; S.init(T_ALL, 3072, G, (int)blockIdx.x);
            pg8::EpiBf16 E{(pg8::bf16_t*)(ws + WS_U), 3072, INP(I_HBIN) + (size_t)j * 3072};
            #ifndef NO_G2
pg8::gemm_phase<pg8::EpiBf16, pg8::StaticOrder, true, true>((PG8_LAS unsigned char*)lds, g, S, E);
#ifdef PROBE_G1
            pg8::gemm_phase<pg8::EpiBf16, pg8::StaticOrder, true, true>((PG8_LAS unsigned char*)lds, g, S, E);
#endif
#endif
        } else {
            pg8::Gemm g{(const pg8::bf16_t*)(ws + WS_H), (const pg8::bf16_t*)(ws + WS_W1), T_ALL, 3072, 1024}; pg8::StaticOrder S; S.init(T_ALL, 3072, G, (int)blockIdx.x);
            float* ck = OUTP() + (size_t)T_ALL * 1024 + (size_t)j * 256 * 1024;
            static_assert(WS_K == WS_Q + (72u << 20) && WS_V == WS_Q + (152u << 20), "EpiQKV buffer spacing");
            pg8::EpiQKV E{ws + WS_Q, ck, (const float*)(ws + WS_ROPE), (const float*)(ws + WS_ROPE) + 1024};
            #ifndef NO_G3
pg8::gemm_phase<pg8::EpiQKV, pg8::StaticOrder, true, true>((PG8_LAS unsigned char*)lds, g, S, E);
#ifdef PROBE_G1
            pg8::gemm_phase<pg8::EpiQKV, pg8::StaticOrder, true, true>((PG8_LAS unsigned char*)lds, g, S, E);
#endif
#endif
        }
        GSYNC();
        if (!isffn) {
            if (ishy) { phase_conv3(j, lds); GSYNC();
#ifndef NO_FFT
#ifdef PROBE_FFT
phase_fft(j, lds, true); GSYNC();
#endif
phase_fft(j, lds, false);
#endif
 GSYNC(); phase_gate(j, lds); GSYNC(); }
            else {
#ifndef NO_ATT
phase_attention(lds);
#ifdef PROBE_ATT
 GSYNC(); phase_attention(lds);
#endif
#endif
 GSYNC(); phase_combine(layer); GSYNC(); }
        }
        {
            const pg8::bf16_t* A = isffn ? (const pg8::bf16_t*)(ws + WS_ACT) : (const pg8::bf16_t*)(ws + WS_H);
            const pg8::bf16_t* B = isffn ? (const pg8::bf16_t*)(ws + WS_WDN) : (const pg8::bf16_t*)(ws + WS_W2);
            const int K = isffn ? DFF : 1024;
            pg8::Gemm g{A, B, T_ALL, 1024, K}; pg8::StaticOrder S; S.init(T_ALL, 1024, G, (int)blockIdx.x);
            const float* bias = (!isffn && ishy) ? INP(I_HBOUT) + (size_t)j * 1024 : nullptr;
            pg8::EpiRes E{(pg8::bf16_t*)(ws + WS_X16), INP(I_XP), INP(I_XS), mods_l + (isffn ? 5 : 2) * 1024, bias, s == 0 ? 1 : 0};
            #ifndef NO_G4
pg8::gemm_phase<pg8::EpiRes, pg8::StaticOrder, true, true>((PG8_LAS unsigned char*)lds, g, S, E);
#endif
        }
        if (isffn && layer < 3 && G == 256 && blockIdx.x >= 64) {
            phase_convert_weights(layer + 1, lds, 1, (int)blockIdx.x - 64, 192);
            if ((layer + 1) & 1) phase_filter((layer + 1) >> 1, lds, (int)blockIdx.x - 64, 192);
        }
        GSYNC();
    }
#ifdef PROBE_SYNC
#pragma unroll 1
    for (int q = 0; q < 40; ++q) GSYNC();
#endif
    phase_final_norm();
}

extern "C" void kernel_launch(void* const* d_in, const int* in_sizes, int n_in, void* d_out, int out_size, void* d_ws, size_t ws_size, hipStream_t stream) {
    static int grid_blocks = 0;
    if (grid_blocks == 0) {
        if (n_in != 31 || ws_size < WS_END) { fprintf(stderr, "kernel_launch: unexpected n_in %d or ws_size %zu (need %zu)\n", n_in, ws_size, (size_t)WS_END); grid_blocks = -1; return; }
        int dev = 0, cus = 0, per_cu = 0;
        hipGetDevice(&dev);
        hipDeviceGetAttribute(&cus, hipDeviceAttributeMultiprocessorCount, dev);
        if (hipFuncSetAttribute((const void*)fwd_megakernel, hipFuncAttributeMaxDynamicSharedMemorySize, LDS_BYTES) != hipSuccess) { fprintf(stderr, "kernel_launch: hipFuncSetAttribute failed\n"); grid_blocks = -1; return; }
        if (hipOccupancyMaxActiveBlocksPerMultiprocessor(&per_cu, (const void*)fwd_megakernel, 512, LDS_BYTES) != hipSuccess || per_cu < 1) { fprintf(stderr, "kernel_launch: occupancy query says %d\n", per_cu); per_cu = 1; }
        (void)hipGetLastError();
        grid_blocks = cus * 1;
        fprintf(stderr, "kernel_launch: cus %d per_cu %d grid %d ws %zu\n", cus, per_cu, grid_blocks, ws_size);
    }
    if (grid_blocks < 0) return;
    Params p{};
    for (int i = 0; i < 31; ++i) p.in[i] = (const float*)d_in[i];
    p.out = (float*)d_out; p.ws = (unsigned char*)d_ws;
    void* args[] = {&p};
    hipError_t e = hipLaunchCooperativeKernel((const void*)fwd_megakernel, dim3(grid_blocks), dim3(512), args, LDS_BYTES, stream);
    if (e != hipSuccess) fprintf(stderr, "kernel_launch: cooperative launch failed: %s (grid %d)\n", hipGetErrorString(e), grid_blocks);
}
```

```cpp
#include <hip/hip_runtime.h>
#include <hip/hip_bf16.h>
#include <hip/hip_cooperative_groups.h>
#include <cstdio>
#include <cstdint>
namespace cg = cooperative_groups;
__device__ __forceinline__ int tidx() { int t = threadIdx.x; asm volatile("" : "+v"(t)); return t; }

namespace pg8 {
#define PG8_LAS __attribute__((address_space(3)))
typedef unsigned short bf16_t;
typedef short bf16x8 __attribute__((ext_vector_type(8)));
typedef float f32x4 __attribute__((ext_vector_type(4)));
typedef unsigned u32x4 __attribute__((ext_vector_type(4)));
constexpr int BM = 256, BK = 64, HALF = 128, HTB = HALF * BK * 2  , STAGE_BYTES = 8 * HTB, NXCD = 8, WGM = 8;

__host__ __device__ __forceinline__ int lds_byte(int r, int c) { const int st = (r >> 4) * 2 + (c >> 5), rr = r & 15, cc = c & 31, ob = rr * 64 + cc * 2; return st * 1024 + (ob ^ (((ob >> 9) & 1) << 5)); }
__host__ __device__ __forceinline__ void stage_rc(int b, int& R, int& C) { const int st = b / 1024, sb = b % 1024, swz = sb ^ (((sb >> 9) & 1) << 5); R = (st >> 1) * 16 + swz / 64; C = (st & 1) * 32 + (swz % 64) / 2; }
__host__ __device__ __forceinline__ int perm32(int rho) { const int n = rho >> 4, i = rho & 15; return 8 * (i >> 2) + 4 * n + (i & 3); }

struct Unit { int pm, pn, kt0, nkt, split; };
struct Gemm { const bf16_t* A; const bf16_t* Bt; int M, N, K; };

struct StaticOrder {
    int nM, nN, nwg, G, c;
    __host__ __device__ void init(int M, int N, int G_, int c_) { nM = M / BM; nN = N / BM; nwg = nM * nN; G = G_; c = c_; }
    __host__ __device__ bool next(int i, Unit& u) const {
        const long L = (long)i * G + c; if (L >= nwg) return false;
        int wgid = (int)L; { const int q = nwg / NXCD, r = nwg % NXCD, xcd = wgid % NXCD, off = wgid / NXCD; wgid = (xcd < r ? xcd * (q + 1) : r * (q + 1) + (xcd - r) * q) + off; }
        const int nig = WGM * nN, gid = wgid / nig, fm = gid * WGM, gsz = (nM - fm) < WGM ? (nM - fm) : WGM;
        u.pm = fm + ((wgid % nig) % gsz); u.pn = (wgid % nig) / gsz; u.kt0 = 0; u.nkt = 0; u.split = -1; return true;
    }
    __device__ __forceinline__ void a_ready(const Unit&) const {}
    __device__ __forceinline__ void done(const Unit&) const {}
};

__device__ __forceinline__ unsigned cvt_pk_bf16(float lo, float hi) { unsigned r; asm volatile("v_cvt_pk_bf16_f32 %0, %1, %2" : "=v"(r) : "v"(lo), "v"(hi)); return r; }

struct SplitOrder {
    int G, c, nt;
    __host__ __device__ void init(int K, int G_, int c_) { nt = K / BK; G = G_; c = c_; }
    __host__ __device__ bool next(int i, Unit& u) const {
        const int L = i * G + c; if (L >= 512 + 256) return false;
        int tile;
        if (L < 512) { tile = (L % NXCD) * 64 + L / NXCD; u.kt0 = 0; u.nkt = 0; u.split = -1; }
        else { const int r = L - 512, s = r & 3; tile = 512 + (r >> 2);
            const int q = (nt / 4) & ~1, rp = (nt - 4 * q) / 2;
            u.split = s; u.nkt = q + (s < rp ? 2 : 0); u.kt0 = s * q + 2 * (s < rp ? s : rp); }
        const int gid = tile >> 5, w = tile & 31;
        u.pm = gid * 8 + (w & 7); u.pn = w >> 3; return true;
    }
    __device__ __forceinline__ void a_ready(const Unit&) const {}
    __device__ __forceinline__ void done(const Unit&) const {}
};
typedef unsigned u32x2 __attribute__((ext_vector_type(2)));
struct EpiBf16 {
    static constexpr bool PERM = true, AFTER_DRAIN = false;
    bf16_t* O; int ldc; const float* bias;
    __device__ __forceinline__ void operator()(const f32x4 (&acc)[2][2][4][2], const Unit& u, int wr, int wc, int fr, int fq) const {
        const int row0 = u.pm * BM + wr * 64 + fr; const int col0 = u.pn * BM + wc * 32 + 8 * fq;
        f32x4 bv[2][2];
#pragma unroll
        for (int bj = 0; bj < 2; ++bj)
#pragma unroll
            for (int n = 0; n < 2; ++n) bv[bj][n] = *(const f32x4*)(bias + col0 + bj * HALF + 4 * n);
#pragma unroll
        for (int ai = 0; ai < 2; ++ai)
#pragma unroll
            for (int m = 0; m < 4; ++m) { bf16_t* rowp = O + (size_t)(row0 + ai * HALF + m * 16) * ldc + col0;
#pragma unroll
                for (int bj = 0; bj < 2; ++bj) { const f32x4 v0 = acc[ai][bj][m][0] + bv[bj][0], v1 = acc[ai][bj][m][1] + bv[bj][1];
                    u32x4 w; w.x = cvt_pk_bf16(v0[0], v0[1]); w.y = cvt_pk_bf16(v0[2], v0[3]); w.z = cvt_pk_bf16(v1[0], v1[1]); w.w = cvt_pk_bf16(v1[2], v1[3]);
                    *(u32x4*)(rowp + bj * HALF) = w; } }
    }
};
__device__ __forceinline__ float silu_f(float x) { return x * __builtin_amdgcn_rcpf(1.0f + __builtin_amdgcn_exp2f(-1.4426950408889634f * x)); }
struct EpiSwiglu {
    static constexpr bool PERM = true, AFTER_DRAIN = false;
    bf16_t* O;
    __device__ __forceinline__ void operator()(const f32x4 (&acc)[2][2][4][2], const Unit& u, int wr, int wc, int fr, int fq) const {
        const int row0 = u.pm * BM + wr * 64 + fr; const int col0 = u.pn * HALF + wc * 32 + 8 * fq;
#pragma unroll
        for (int ai = 0; ai < 2; ++ai)
#pragma unroll
            for (int m = 0; m < 4; ++m) { bf16_t* rowp = O + (size_t)(row0 + ai * HALF + m * 16) * 2816 + col0;
                const f32x4 g0 = acc[ai][0][m][0], g1 = acc[ai][0][m][1], u0 = acc[ai][1][m][0], u1 = acc[ai][1][m][1];
                float r[8];
#pragma unroll
                for (int i = 0; i < 4; ++i) { r[i] = silu_f(g0[i]) * u0[i]; r[4 + i] = silu_f(g1[i]) * u1[i]; }
                u32x4 w; w.x = cvt_pk_bf16(r[0], r[1]); w.y = cvt_pk_bf16(r[2], r[3]); w.z = cvt_pk_bf16(r[4], r[5]); w.w = cvt_pk_bf16(r[6], r[7]);
                *(u32x4*)rowp = w; }
    }
};
struct EpiRes {
    static constexpr bool PERM = true, AFTER_DRAIN = false;
    bf16_t* X16; const float* xs_ctx; const float* xs_smp; const float* gate; const float* bias; int first;
    __device__ __forceinline__ void operator()(const f32x4 (&acc)[2][2][4][2], const Unit& u, int wr, int wc, int fr, int fq) const {
        const int g = u.pm >> 4; const float* gp = gate + (size_t)g * 6144;
        const int col0 = u.pn * BM + wc * 32 + 8 * fq;
#pragma unroll
        for (int bj = 0; bj < 2; ++bj) {
            const int co = col0 + bj * HALF;
            const f32x4 gv0 = *(const f32x4*)(gp + co), gv1 = *(const f32x4*)(gp + co + 4);
            const f32x4 bv0 = bias ? *(const f32x4*)(bias + co) : (f32x4){0.f, 0.f, 0.f, 0.f}, bv1 = bias ? *(const f32x4*)(bias + co + 4) : (f32x4){0.f, 0.f, 0.f, 0.f};
#pragma unroll
            for (int ai = 0; ai < 2; ++ai)
#pragma unroll
                for (int m = 0; m < 4; ++m) { const int row = u.pm * BM + ai * HALF + wr * 64 + m * 16 + fr;
                    bf16_t* xo = X16 + (size_t)row * 1024 + co;
                    f32x4 o0, o1;
                    if (first) { const float* xs = (g == 0 ? xs_ctx + (size_t)row * 1024 : xs_smp + (size_t)(row - 4096) * 1024) + co; o0 = __builtin_nontemporal_load((const f32x4*)xs); o1 = __builtin_nontemporal_load((const f32x4*)(xs + 4)); }
                    else { const u32x4 w = __builtin_nontemporal_load((const u32x4*)xo); o0 = (f32x4){__builtin_bit_cast(float, w.x << 16), __builtin_bit_cast(float, w.x & 0xffff0000u), __builtin_bit_cast(float, w.y << 16), __builtin_bit_cast(float, w.y & 0xffff0000u)};
                        o1 = (f32x4){__builtin_bit_cast(float, w.z << 16), __builtin_bit_cast(float, w.z & 0xffff0000u), __builtin_bit_cast(float, w.w << 16), __builtin_bit_cast(float, w.w & 0xffff0000u)}; }
                    const f32x4 n0 = o0 + gv0 * (acc[ai][bj][m][0] + bv0), n1 = o1 + gv1 * (acc[ai][bj][m][1] + bv1);
                    u32x4 wn; wn.x = cvt_pk_bf16(n0[0], n0[1]); wn.y = cvt_pk_bf16(n0[2], n0[3]); wn.z = cvt_pk_bf16(n1[0], n1[1]); wn.w = cvt_pk_bf16(n1[2], n1[3]);
                    *(u32x4*)xo = wn; }
        }
    }
};
constexpr float QSCALE = 0.125f * 1.4426950408889634f;
struct EpiQKV {
    static constexpr bool PERM = false, AFTER_DRAIN = false;
    unsigned char* qbase; float* ck; const float* rcos; const float* rsin;
    __device__ __forceinline__ void operator()(const f32x4 (&acc)[2][2][4][2], const Unit& u, int wr, int wc, int fr, int fq) const {
        const int part = u.pn >> 2, colt = (u.pn & 3) * BM, g = u.pm >> 4;
        const int col0 = colt + wc * 32 + 4 * fq;
        const bool rope = (g > 0) && (part < 2);
        const int axis = wc & 1;
        bf16_t* const dstb = (bf16_t*)(qbase + (size_t)part * (72u << 20) + (size_t)(part >> 1) * (8u << 20));
        float* const cdst = ck + (size_t)(part >> 1) * ((size_t)16 * 2 * 256 * 1024);
#pragma unroll
        for (int ai = 0; ai < 2; ++ai)
#pragma unroll
            for (int m = 0; m < 4; ++m) {
                const int row = u.pm * BM + ai * HALF + wr * 64 + m * 16 + fr;
                const int t = row & 4095;
                f32x4 c4 = (f32x4){1.f, 1.f, 1.f, 1.f}, s4 = (f32x4){0.f, 0.f, 0.f, 0.f};
                if (rope) { const int posi = axis ? (t & 63) : (t >> 6); c4 = *(const f32x4*)(rcos + posi * 16 + 4 * fq); s4 = *(const f32x4*)(rsin + posi * 16 + 4 * fq); }
                size_t drow = (size_t)row;
                if (part != 0 && g > 0) drow = (size_t)(4096 + (g - 1) * 4608 + 512 + t);
                bf16_t* base = dstb + drow * 1024 + col0;
#pragma unroll
                for (int bj = 0; bj < 2; ++bj) {
                    const f32x4 v0 = acc[ai][bj][m][0], v1 = acc[ai][bj][m][1];
                    const bool odd = fq & 1; const int cofs = bj * HALF + (odd ? 12 : 0);
                    if (g == 0 && part != 0) { float* o = cdst + (size_t)(row >> 8) * (2 * 256 * 1024) + (size_t)(row & 255) * 1024 + col0 + cofs;
                        const f32x4 snd = odd ? v0 : v1; f32x4 rcv; rcv[0] = __shfl_xor(snd[0], 16); rcv[1] = __shfl_xor(snd[1], 16); rcv[2] = __shfl_xor(snd[2], 16); rcv[3] = __shfl_xor(snd[3], 16);
                        __builtin_nontemporal_store(odd ? rcv : v0, (f32x4*)o); __builtin_nontemporal_store(odd ? v1 : rcv, (f32x4*)(o + 4)); }
                    f32x4 o0 = v0 * c4 - v1 * s4, o1 = v1 * c4 + v0 * s4;
                    if (part == 0) { o0 = o0 * QSCALE; o1 = o1 * QSCALE; }
                    u32x2 w0, w1; w0.x = cvt_pk_bf16(o0[0], o0[1]); w0.y = cvt_pk_bf16(o0[2], o0[3]); w1.x = cvt_pk_bf16(o1[0], o1[1]); w1.y = cvt_pk_bf16(o1[2], o1[3]);
                    const u32x2 snd = odd ? w0 : w1; u32x2 rcv; rcv.x = __shfl_xor(snd.x, 16); rcv.y = __shfl_xor(snd.y, 16);
                    u32x4 wo; if (odd) { wo.x = rcv.x; wo.y = rcv.y; wo.z = w1.x; wo.w = w1.y; } else { wo.x = w0.x; wo.y = w0.y; wo.z = rcv.x; wo.w = rcv.y; }
                    *(u32x4*)(base + cofs) = wo; }
            }
    }
};

template <class Epi, class Sched, bool ALIGN_EPI = false, bool SP2 = false>
__device__ __forceinline__ void gemm_phase(PG8_LAS unsigned char* lds, const Gemm g, const Sched& S, const Epi& E) {
    const int tid = tidx(), wid = __builtin_amdgcn_readfirstlane(tid >> 6), lane = tid & 63, wr = wid >> 2, wc = wid & 3, fr = lane & 15, fq = lane >> 4;
    const int K = g.K, nt = K / BK;
    unsigned voffA[2], voffB[2];
#pragma unroll
    for (int i = 0; i < 2; ++i) { int R, C; stage_rc(tid * 16 + i * 8192, R, C); const int Rb = Epi::PERM ? ((R & ~31) + perm32(R & 31)) : R;
        voffA[i] = (unsigned)(R * K + C) * 2u; voffB[i] = (unsigned)(Rb * K + C) * 2u; }
    const size_t kstep = (size_t)(BK * 2);
    const size_t hstep = (size_t)HALF * K * 2;
    const size_t tstep = 2 * hstep;
    const unsigned ldsw = (unsigned)wid * 1024u;
    const int aoff = lds_byte(wr * 64 + fr, fq * 8), boff = lds_byte(wc * 32 + fr, fq * 8);
#define PG8_SA(b, h) (((b) * 2 + (h)) * HTB)
#define PG8_SB(b, h) ((4 + (b) * 2 + (h)) * HTB)
#define PG8_STAGE(bufoff, gbase, voff) do { _Pragma("unroll") for (int _i = 0; _i < 2; ++_i) \
        __builtin_amdgcn_global_load_lds((const unsigned*)((const char*)(gbase) + (voff)[_i]), (PG8_LAS unsigned*)(lds + (bufoff) + ldsw + _i * 8192), 16, 0, 0); } while (0)
#define PG8_LDA(dst, b, h) do { _Pragma("unroll") for (int m = 0; m < 4; ++m) _Pragma("unroll") for (int k = 0; k < 2; ++k) dst[m][k] = *(const PG8_LAS bf16x8*)(lds + PG8_SA(b, h) + aoff + m * 2048 + k * 1024); } while (0)
#define PG8_LDB(dst, b, h) do { _Pragma("unroll") for (int n = 0; n < 2; ++n) _Pragma("unroll") for (int k = 0; k < 2; ++k) dst[n][k] = *(const PG8_LAS bf16x8*)(lds + PG8_SB(b, h) + boff + n * 2048 + k * 1024); } while (0)
#define PG8_MMA(ai, bj, At, Bt) do { __builtin_amdgcn_s_setprio(1); _Pragma("unroll") for (int m = 0; m < 4; ++m) _Pragma("unroll") for (int n = 0; n < 2; ++n) _Pragma("unroll") for (int k = 0; k < 2; ++k) \
        acc[ai][bj][m][n] = __builtin_amdgcn_mfma_f32_16x16x32_bf16(Bt[n][k], At[m][k], acc[ai][bj][m][n], 0, 0, 0); __builtin_amdgcn_s_setprio(0); } while (0)
#define PG8_WAIT_V(n) asm volatile("s_waitcnt vmcnt(" #n ")" ::: "memory")
#define PG8_WAIT_L(n) asm volatile("s_waitcnt lgkmcnt(" #n ")" ::: "memory")
#define PG8_BAR __builtin_amdgcn_s_barrier()
#define PG8_SCHED __builtin_amdgcn_sched_barrier(0)
    Unit cur, nxt; int ui = 0;
    if (!S.next(0, cur)) return;
    f32x4 acc[2][2][4][2];
#pragma unroll
    for (int a = 0; a < 2; ++a)
#pragma unroll
        for (int b = 0; b < 2; ++b)
#pragma unroll
            for (int m = 0; m < 4; ++m)
#pragma unroll
                for (int n = 0; n < 2; ++n) acc[a][b][m][n] = (f32x4){0.f, 0.f, 0.f, 0.f};
    bf16x8 At[4][2], B0[2][2], B1[2][2];
    const char* cA = (const char*)g.A + (size_t)cur.pm * tstep + (size_t)cur.kt0 * kstep; const char* cB = (const char*)g.Bt + (size_t)cur.pn * tstep + (size_t)cur.kt0 * kstep;
    S.a_ready(cur);
    if constexpr (SP2) {
        PG8_STAGE(PG8_SB(0, 0), cB, voffB); PG8_STAGE(PG8_SB(0, 1), cB + hstep, voffB); PG8_STAGE(PG8_SA(0, 0), cA, voffA); PG8_STAGE(PG8_SA(0, 1), cA + hstep, voffA);
        if (wr == 1) PG8_BAR;
        PG8_WAIT_V(2); PG8_BAR;
        PG8_STAGE(PG8_SB(1, 0), cB + kstep, voffB); PG8_STAGE(PG8_SA(1, 0), cA + kstep, voffA); PG8_STAGE(PG8_SB(1, 1), cB + hstep + kstep, voffB);
        PG8_WAIT_V(6); PG8_BAR;
    } else {
        PG8_STAGE(PG8_SB(0, 0), cB, voffB); PG8_STAGE(PG8_SA(0, 0), cA, voffA); PG8_STAGE(PG8_SB(0, 1), cB + hstep, voffB); PG8_STAGE(PG8_SA(0, 1), cA + hstep, voffA);
        if (wr == 1) PG8_BAR;
        PG8_WAIT_V(4); PG8_BAR;
        PG8_STAGE(PG8_SB(1, 0), cB + kstep, voffB); PG8_STAGE(PG8_SA(1, 0), cA + kstep, voffA); PG8_STAGE(PG8_SB(1, 1), cB + hstep + kstep, voffB);
        PG8_WAIT_V(6); PG8_BAR;
    }
    for (;;) {
        const bool has_next = S.next(ui + 1, nxt);
        const char* nA = has_next ? (const char*)g.A + (size_t)nxt.pm * tstep + (size_t)nxt.kt0 * kstep : cA; const char* nB = has_next ? (const char*)g.Bt + (size_t)nxt.pn * tstep + (size_t)nxt.kt0 * kstep : cB;
        const int unt = cur.nkt ? cur.nkt : nt;
        for (int t = 0; t < unt; t += 2) {
            const bool last = (t == unt - 2);
            const char* a1 = cA + (size_t)(t + 1) * kstep;
            const char* a2 = last ? nA : cA + (size_t)(t + 2) * kstep; const char* b2 = last ? nB : cB + (size_t)(t + 2) * kstep;
            const char* a3 = a2 + kstep; const char* b3 = b2 + kstep;
            if (last && has_next) S.a_ready(nxt);
            if constexpr (SP2) {
            PG8_LDB(B0, 0, 0); PG8_LDB(B1, 0, 1); PG8_SCHED; PG8_LDA(At, 0, 0); PG8_STAGE(PG8_SA(1, 1), a1 + hstep, voffA);
            PG8_WAIT_V(8); PG8_WAIT_L(0); PG8_BAR; PG8_MMA(0, 0, At, B0); PG8_MMA(0, 1, At, B1); PG8_BAR; PG8_SCHED;
            PG8_LDA(At, 0, 1); PG8_STAGE(PG8_SB(0, 0), b2, voffB); PG8_STAGE(PG8_SB(0, 1), b2 + hstep, voffB); PG8_STAGE(PG8_SA(0, 0), a2, voffA);
            PG8_WAIT_V(8); PG8_WAIT_L(0); PG8_BAR; PG8_MMA(1, 0, At, B0); PG8_MMA(1, 1, At, B1); PG8_BAR; PG8_SCHED;
            PG8_LDB(B0, 1, 0); PG8_LDB(B1, 1, 1); PG8_SCHED; PG8_LDA(At, 1, 0); PG8_STAGE(PG8_SA(0, 1), a2 + hstep, voffA);
            PG8_WAIT_V(8); PG8_WAIT_L(0); PG8_BAR; PG8_MMA(0, 0, At, B0); PG8_MMA(0, 1, At, B1); PG8_BAR; PG8_SCHED;
            PG8_LDA(At, 1, 1); PG8_STAGE(PG8_SB(1, 0), b3, voffB); PG8_STAGE(PG8_SB(1, 1), b3 + hstep, voffB); PG8_STAGE(PG8_SA(1, 0), a3, voffA);
            PG8_WAIT_V(8); PG8_WAIT_L(0); PG8_BAR; PG8_MMA(1, 0, At, B0); PG8_MMA(1, 1, At, B1); PG8_BAR; PG8_SCHED;
            } else {
            PG8_LDB(B0, 0, 0); PG8_SCHED; PG8_LDA(At, 0, 0); PG8_STAGE(PG8_SA(1, 1), a1 + hstep, voffA);
            PG8_WAIT_L(8); PG8_BAR; PG8_WAIT_L(0); PG8_MMA(0, 0, At, B0); PG8_BAR; PG8_SCHED;
            PG8_LDB(B1, 0, 1); PG8_STAGE(PG8_SB(0, 0), b2, voffB);
            PG8_BAR; PG8_WAIT_L(0); PG8_MMA(0, 1, At, B1); PG8_BAR;
            PG8_LDA(At, 0, 1); PG8_STAGE(PG8_SA(0, 0), a2, voffA);
            PG8_BAR; PG8_WAIT_L(0); PG8_MMA(1, 0, At, B0); PG8_BAR; PG8_SCHED;
            PG8_STAGE(PG8_SB(0, 1), b2 + hstep, voffB);
            PG8_WAIT_V(6); PG8_BAR; PG8_MMA(1, 1, At, B1); PG8_BAR;
            PG8_LDB(B0, 1, 0); PG8_SCHED; PG8_LDA(At, 1, 0); PG8_STAGE(PG8_SA(0, 1), a2 + hstep, voffA);
            PG8_WAIT_L(8); PG8_BAR; PG8_WAIT_L(0); PG8_MMA(0, 0, At, B0); PG8_BAR; PG8_SCHED;
            PG8_LDB(B1, 1, 1); PG8_STAGE(PG8_SB(1, 0), b3, voffB);
            PG8_BAR; PG8_WAIT_L(0); PG8_MMA(0, 1, At, B1); PG8_BAR;
            PG8_LDA(At, 1, 1); PG8_STAGE(PG8_SA(1, 0), a3, voffA);
            PG8_BAR; PG8_WAIT_L(0); PG8_MMA(1, 0, At, B0); PG8_BAR; PG8_SCHED;
            PG8_STAGE(PG8_SB(1, 1), b3 + hstep, voffB);
            PG8_WAIT_V(6); PG8_BAR; PG8_MMA(1, 1, At, B1); PG8_BAR;
            }
        }
        if constexpr (ALIGN_EPI) { if (wr == 0) PG8_BAR; }
        if constexpr (!Epi::AFTER_DRAIN) { E(acc, cur, wr, wc, fr, fq); S.done(cur); }
        if (!has_next) break;
#pragma unroll
        for (int a = 0; a < 2; ++a)
#pragma unroll
            for (int b = 0; b < 2; ++b)
#pragma unroll
                for (int m = 0; m < 4; ++m)
#pragma unroll
                    for (int n = 0; n < 2; ++n) acc[a][b][m][n] = (f32x4){0.f, 0.f, 0.f, 0.f};
        cur = nxt; cA = nA; cB = nB; ++ui;
        if constexpr (ALIGN_EPI) { if (wr == 1) PG8_BAR; }
    }
    PG8_WAIT_V(0);
    if constexpr (!ALIGN_EPI) { if (wr == 0) PG8_BAR; }
    PG8_BAR;
    if constexpr (Epi::AFTER_DRAIN) { E.fused(acc, cur, wr, wc, fr, fq, lds, wid, lane); S.done(cur); }
#undef PG8_SA
#undef PG8_SB
#undef PG8_STAGE
#undef PG8_LDA
#undef PG8_LDB
#undef PG8_MMA
#undef PG8_WAIT_V
#undef PG8_WAIT_L
#undef PG8_BAR
#undef PG8_SCHED
}
}
namespace attn {
using bf16 = __hip_bfloat16;
constexpr int NW = 8, QBLK = 32, KVBLK = 64, LD = 1024;
constexpr float SCALE = 0.125f;
constexpr float THR = 8.f;
constexpr size_t SHM_V = KVBLK * 128 * 2, SHM_K = KVBLK * 128 * 2, SHM_ATTN = 2 * SHM_V + 2 * SHM_K + NW * 64 * 4;
using bf16x8 = __attribute__((ext_vector_type(8))) short;
using s16x4  = __attribute__((ext_vector_type(4))) short;
using f32x16 = __attribute__((ext_vector_type(16))) float;
using u32x4  = __attribute__((ext_vector_type(4))) unsigned;
#define KSWZ(row, colB) ((row) * 256 + ((colB) ^ (((row) & 7) << 4)))
#define SBAR() __builtin_amdgcn_sched_barrier(0)
__device__ __forceinline__ int crow(int r, int hi) { return (r & 3) + 8 * (r >> 2) + 4 * hi; }
__device__ __forceinline__ unsigned cvtpk(float lo, float hi) { unsigned r; asm volatile("v_cvt_pk_bf16_f32 %0, %1, %2" : "=v"(r) : "v"(lo), "v"(hi)); return r; }
__device__ __forceinline__ bf16x8 ld8(const bf16* p) { return *reinterpret_cast<const bf16x8*>(p); }

constexpr float THRL = THR * 1.4426950408889634f;
template <bool FIRST> __device__ __forceinline__ void partialSM(f32x16& p0, f32x16& p1, float& m_reg, float& alpha) {
  float pmax = fmaxf(fmaxf(p0[0], p0[1]), p1[0]);
#pragma unroll
  for (int r = 2; r < 16; r += 2) pmax = fmaxf(fmaxf(pmax, p0[r]), p0[r + 1]);
#pragma unroll
  for (int r = 1; r < 15; r += 2) pmax = fmaxf(fmaxf(pmax, p1[r]), p1[r + 1]);
  pmax = fmaxf(pmax, p1[15]);
  { auto rr = __builtin_amdgcn_permlane32_swap(__float_as_uint(pmax), __float_as_uint(pmax), false, false);
    pmax = fmaxf(__uint_as_float(rr[0]), __uint_as_float(rr[1])); }
  alpha = 1.f;
  if (FIRST || !__builtin_expect(__all(pmax <= THRL), 1)) {
    const float dl = FIRST ? pmax : fmaxf(pmax, 0.f);
    m_reg += dl; if (!FIRST) alpha = __builtin_amdgcn_exp2f(-dl);
#pragma unroll
    for (int r = 0; r < 16; ++r) { p0[r] -= dl; p1[r] -= dl; }
  }
#pragma unroll
  for (int r = 0; r < 16; ++r) p0[r] = __builtin_amdgcn_exp2f(p0[r]);
}
__device__ __forceinline__ void finishSM(f32x16& p0, f32x16& p1, float alpha, float& l_reg, bf16x8& pa0, bf16x8& pa1, bf16x8& pa2, bf16x8& pa3) {
#pragma unroll
  for (int r = 0; r < 16; ++r) p1[r] = __builtin_amdgcn_exp2f(p1[r]);
  float ps;
  { const f32x16 t = p0 + p1; typedef float f32x8v __attribute__((ext_vector_type(8))); typedef float f32x4v __attribute__((ext_vector_type(4))); typedef float f32x2v __attribute__((ext_vector_type(2)));
    const f32x8v t8 = __builtin_shufflevector(t, t, 0, 1, 2, 3, 4, 5, 6, 7) + __builtin_shufflevector(t, t, 8, 9, 10, 11, 12, 13, 14, 15);
    const f32x4v t4 = __builtin_shufflevector(t8, t8, 0, 1, 2, 3) + __builtin_shufflevector(t8, t8, 4, 5, 6, 7);
    const f32x2v t2 = __builtin_shufflevector(t4, t4, 0, 1) + __builtin_shufflevector(t4, t4, 2, 3); ps = t2.x + t2.y; }
  { auto rr = __builtin_amdgcn_permlane32_swap(__float_as_uint(ps), __float_as_uint(ps), false, false);
    ps = __uint_as_float(rr[0]) + __uint_as_float(rr[1]); }
  l_reg = l_reg * alpha + ps;
#define PK4(P, BASE, OUT) do { unsigned a0 = cvtpk(P[BASE + 0], P[BASE + 1]), a1 = cvtpk(P[BASE + 2], P[BASE + 3]);   \
    unsigned b0 = cvtpk(P[BASE + 4], P[BASE + 5]), b1 = cvtpk(P[BASE + 6], P[BASE + 7]);                              \
    auto r0 = __builtin_amdgcn_permlane32_swap(a0, b0, false, false); auto r1 = __builtin_amdgcn_permlane32_swap(a1, b1, false, false); \
    u32x4 w = {r0[0], r1[0], r0[1], r1[1]}; OUT = *reinterpret_cast<bf16x8*>(&w); } while (0)
  PK4(p0, 0, pa0); PK4(p0, 8, pa1); PK4(p1, 0, pa2); PK4(p1, 8, pa3);
#undef PK4
}
__device__ __forceinline__ void qkt(f32x16& p0, f32x16& p1, const bf16* Ks, const bf16x8* qr, int r32, int hi, float m_ref) {
  { const float nm = -m_ref;
#pragma unroll
    for (int r = 0; r < 16; ++r) { p0[r] = nm; p1[r] = nm; } }
#pragma unroll
  for (int d0 = 0; d0 < 4; ++d0) { int cb = (d0 * 16 + hi * 8) * 2;
    bf16x8 b0 = *reinterpret_cast<const bf16x8*>((const char*)Ks + KSWZ(r32, cb));
    bf16x8 b1 = *reinterpret_cast<const bf16x8*>((const char*)Ks + KSWZ(32 + r32, cb));
    p0 = __builtin_amdgcn_mfma_f32_32x32x16_bf16(b0, qr[d0], p0, 0, 0, 0);
    p1 = __builtin_amdgcn_mfma_f32_32x32x16_bf16(b1, qr[d0], p1, 0, 0, 0); }
}
__device__ __forceinline__ int v_st(int k, int c) { const int kk = (k & ~0xC) | ((k & 4) << 1) | ((k & 8) >> 1); return ((kk >> 3) * 4 + (c >> 5)) * 512 + ((kk & 7) * 32 + (c & 31)) * 2; }
__device__ __forceinline__ int v_rd_base(int lane) { return ((lane & 3) << 3) | (((lane >> 2) & 3) << 6) | (((lane >> 4) & 1) << 5) | (((lane >> 5) & 1) << 8); }
constexpr int v_rd_off(int d0, int ks, int half) { return d0 * 512 + ks * 4096 + half * 2048; }
template <int OFF> __device__ __forceinline__ s16x4 tr_read(int vb) {
  s16x4 r; asm volatile("ds_read_b64_tr_b16 %0, %1 offset:%2" : "=&v"(r) : "v"(vb), "i"(OFF) : "memory"); return r;
}
template <int D0> __device__ __forceinline__ void pv_one(f32x16& od, int vb, bf16x8 pa0, bf16x8 pa1, bf16x8 pa2, bf16x8 pa3) {
  const s16x4 l0 = tr_read<v_rd_off(D0, 0, 0)>(vb), h0 = tr_read<v_rd_off(D0, 0, 1)>(vb), l1 = tr_read<v_rd_off(D0, 1, 0)>(vb), h1 = tr_read<v_rd_off(D0, 1, 1)>(vb);
  const s16x4 l2 = tr_read<v_rd_off(D0, 2, 0)>(vb), h2 = tr_read<v_rd_off(D0, 2, 1)>(vb), l3 = tr_read<v_rd_off(D0, 3, 0)>(vb), h3 = tr_read<v_rd_off(D0, 3, 1)>(vb);
  asm volatile("s_waitcnt lgkmcnt(0)" ::: "memory"); SBAR();
#define PK(L, H) (bf16x8){L[0], L[1], L[2], L[3], H[0], H[1], H[2], H[3]}
  od = __builtin_amdgcn_mfma_f32_32x32x16_bf16(pa0, PK(l0, h0), od, 0, 0, 0);
  od = __builtin_amdgcn_mfma_f32_32x32x16_bf16(pa1, PK(l1, h1), od, 0, 0, 0);
  od = __builtin_amdgcn_mfma_f32_32x32x16_bf16(pa2, PK(l2, h2), od, 0, 0, 0);
  od = __builtin_amdgcn_mfma_f32_32x32x16_bf16(pa3, PK(l3, h3), od, 0, 0, 0);
#undef PK
}
__device__ __forceinline__ void pv_d0(f32x16* o, int vb, bf16x8 pa0, bf16x8 pa1, bf16x8 pa2, bf16x8 pa3) {
  pv_one<0>(o[0], vb, pa0, pa1, pa2, pa3); pv_one<1>(o[1], vb, pa0, pa1, pa2, pa3); pv_one<2>(o[2], vb, pa0, pa1, pa2, pa3); pv_one<3>(o[3], vb, pa0, pa1, pa2, pa3);
}
struct AUnit { const bf16* Q; const bf16* K; const bf16* V; bf16* O; int seq; };
template <class Units> __device__ __forceinline__ void attn_run(const Units& U, char* lds) {
  const int tid = tidx(), wid = tid >> 6, lane = tid & 63, r32 = lane & 31, hi = lane >> 5;
  bf16* V_lds = (bf16*)lds; bf16* K_lds = (bf16*)(lds + 2 * SHM_V);
  float* ws = (float*)(lds + 2 * SHM_V + 2 * SHM_K) + wid * 64; float* li_l = ws; float* al_l = ws + 32;
  const int sr = tid >> 4, sc = (tid & 15) * 8, vst0 = v_st(sr, sc), vst1 = v_st(32 + sr, sc);
  const int kr = tid >> 3, kc = (tid & 7) * 8, kst = KSWZ(kr, kc * 2);
  const int vb0 = (int)(uintptr_t)V_lds + v_rd_base(lane);
  struct { bf16x8 vs0, vs1, ks0; } sr_[2];
  bf16x8 qr[4];
  constexpr int SE = 0, SO = 1;
  const unsigned voff0 = (unsigned)(sr * LD + sc), voff1 = (unsigned)((32 + sr) * LD + sc), koff = (unsigned)(kr * LD + kc);
#define SLOADU(i, UN, k0) do { const bf16* vt_ = (UN).V + (size_t)(k0) * LD; const bf16* kt_ = (UN).K + (size_t)(k0) * LD; \
    sr_[i].vs0 = ld8(vt_ + voff0); sr_[i].vs1 = ld8(vt_ + voff1); sr_[i].ks0 = ld8(kt_ + koff); } while (0)
#define QLOADU(UN) do { const bf16* Qw_ = (UN).Q + (long)(wid * QBLK + r32) * LD + hi * 8; \
    _Pragma("unroll") for (int d0 = 0; d0 < 4; ++d0) qr[d0] = __builtin_nontemporal_load(reinterpret_cast<const bf16x8*>(Qw_ + d0 * 16)); } while (0)
#define SLOAD(i, k0) SLOADU(i, cur, k0)
#define SWRITE(b, i) do { *(bf16x8*)((char*)V_lds + (b) * SHM_V + vst0) = sr_[i].vs0;          \
    *(bf16x8*)((char*)V_lds + (b) * SHM_V + vst1) = sr_[i].vs1;               \
    *(bf16x8*)((char*)K_lds + (b) * SHM_K + kst) = sr_[i].ks0; } while (0)
#define SWAIT() asm volatile("s_waitcnt vmcnt(3)" ::: "memory")
#define RESC(a) do { if (__any((a) < 1.f)) { if (hi == 0) al_l[r32] = (a); asm volatile("s_waitcnt lgkmcnt(0)" ::: "memory"); \
    _Pragma("unroll") for (int d = 0; d < 4; ++d) _Pragma("unroll") for (int r = 0; r < 16; ++r) o[d][r] *= al_l[crow(r, hi)]; } } while (0)
  { AUnit f; if (U.get(0, f)) { SLOADU(SE, f, 0); } }
#pragma unroll 1
  for (int ui = 0; ; ++ui) {
    AUnit cur; if (!U.get(ui, cur)) break;
    QLOADU(cur);
    float m_reg = 0.f, l_reg = 0; f32x16 o[4] = {};
    f32x16 pA0, pA1, pB0, pB1; float alA, alB; bf16x8 pa0, pa1, pa2, pa3; const int NT = cur.seq / KVBLK;
    SWRITE(0, SE); __syncthreads();
    qkt(pA0, pA1, K_lds, qr, r32, hi, 0.f); partialSM<true>(pA0, pA1, m_reg, alA);
    SLOAD(SO, KVBLK); if (2 < NT) SLOAD(SE, 2 * KVBLK);
    SWAIT(); SWRITE(1, SO); __syncthreads();
    for (int j = 1; j + 1 < NT; j += 2) {
      SBAR(); qkt(pB0, pB1, (bf16*)((char*)K_lds + SHM_K), qr, r32, hi, m_reg);
      finishSM(pA0, pA1, alA, l_reg, pa0, pa1, pa2, pa3); SBAR();
      SLOAD(SO, (j + 2) * KVBLK); SBAR();
      pv_d0(o, vb0, pa0, pa1, pa2, pa3); partialSM<false>(pB0, pB1, m_reg, alB);
      __syncthreads(); SWAIT(); SWRITE(0, SE);
      RESC(alB); __syncthreads();
      SBAR(); qkt(pA0, pA1, K_lds, qr, r32, hi, m_reg);
      finishSM(pB0, pB1, alB, l_reg, pa0, pa1, pa2, pa3); SBAR();
      if (j + 3 < NT) SLOAD(SE, (j + 3) * KVBLK); SBAR();
      pv_d0(o, vb0 + (int)SHM_V, pa0, pa1, pa2, pa3); partialSM<false>(pA0, pA1, m_reg, alA);
      __syncthreads(); SWAIT(); SWRITE(1, SO);
      RESC(alA); __syncthreads();
    }
    SBAR(); qkt(pB0, pB1, (bf16*)((char*)K_lds + SHM_K), qr, r32, hi, m_reg);
    finishSM(pA0, pA1, alA, l_reg, pa0, pa1, pa2, pa3); SBAR();
    { AUnit nxt; if (U.get(ui + 1, nxt)) { SLOADU(SE, nxt, 0); } } SBAR();
    pv_d0(o, vb0, pa0, pa1, pa2, pa3); partialSM<false>(pB0, pB1, m_reg, alB);
    __syncthreads(); RESC(alB);
    finishSM(pB0, pB1, alB, l_reg, pa0, pa1, pa2, pa3); SBAR();
    pv_d0(o, vb0 + (int)SHM_V, pa0, pa1, pa2, pa3);
    if (hi == 0) li_l[r32] = l_reg; asm volatile("s_waitcnt lgkmcnt(0)" ::: "memory");
    float rli[16];
#pragma unroll
    for (int r = 0; r < 16; ++r) rli[r] = __builtin_amdgcn_rcpf(li_l[crow(r, hi)]);
    bf16* Ow = cur.O + (long)(wid * QBLK) * LD;
#pragma unroll
    for (int r = 0; r < 16; ++r) { int orow = crow(r, hi);
#pragma unroll
      for (int d0 = 0; d0 < 4; ++d0) Ow[(long)orow * LD + d0 * 32 + r32] = __float2bfloat16(o[d0][r] * rli[r]); }
    __syncthreads();
  }
#undef SLOADU
#undef QLOADU
#undef SLOAD
#undef SWRITE
#undef SWAIT
#undef RESC
}
#undef KSWZ
#undef SBAR
}

#define FFT_HD __device__ __forceinline__
#ifndef FFT_HD
#define FFT_HD __host__ __device__ __forceinline__
#endif
typedef float cf __attribute__((ext_vector_type(2)));
FFT_HD cf cmul(cf a, cf b) { const cf t = {-a.y, a.x}; return a * b.x + t * b.y; }
FFT_HD cf cmulc(cf a, cf b) { const cf t = {a.y, -a.x}; return a * b.x + t * b.y; }
FFT_HD int fpad(int i) { return i + (i >> 4); }
FFT_HD cf twid(float rev) {
#if defined(__HIP_DEVICE_COMPILE__)
  return cf{__builtin_amdgcn_cosf(rev), -__builtin_amdgcn_sinf(rev)};
#else
  return cf{cosf(6.283185307179586f * rev), -sinf(6.283185307179586f * rev)};
#endif
}
FFT_HD cf rot16(cf d, int k) {
  const float s = 0.70710678119f, c1 = 0.92387953251f, s1 = 0.38268343236f;
  switch (k & 15) {
    case 0: return d;
    case 4: return cf{d.y, -d.x};
    case 8: return cf{-d.x, -d.y};
    case 12: return cf{-d.y, d.x};
    case 2: return cf{(d.x + d.y) * s, (d.y - d.x) * s};
    case 6: return cf{(d.y - d.x) * s, -(d.x + d.y) * s};
    case 10: return cf{-(d.x + d.y) * s, (d.x - d.y) * s};
    case 14: return cf{(d.x - d.y) * s, (d.x + d.y) * s};
    case 1: return cmul(d, cf{c1, -s1});
    case 3: return cmul(d, cf{s1, -c1});
    case 5: return cmul(d, cf{-s1, -c1});
    case 7: return cmul(d, cf{-c1, -s1});
    case 9: return cmul(d, cf{-c1, s1});
    case 11: return cmul(d, cf{-s1, c1});
    case 13: return cmul(d, cf{s1, c1});
    default: return cmul(d, cf{c1, s1});
  }
}
template <int LOG_R, bool UNIT, bool ZHALF> FFT_HD void dif_group(cf (&v)[1 << LOG_R], cf w0) {
  constexpr int R = 1 << LOG_R;
  cf wk = w0;
#pragma unroll
  for (int k = 0; k < LOG_R; ++k) {
    const int half = R >> (k + 1);
#pragma unroll
    for (int m = 0; m < R; ++m) {
      if ((m & half) == 0) {
        const int mm = m & (half - 1);
        cf d;
        if (ZHALF && k == 0) { d = v[m]; }
        else { const cf a = v[m], b = v[m + half]; d = a - b; v[m] = a + b; }
        if (!UNIT) d = cmul(d, wk);
        v[m + half] = rot16(d, (mm << k) * (16 / R));
      }
    }
    if (!UNIT) wk = cmul(wk, wk);
  }
}
template <int LOG_R, bool UNIT, bool LOWONLY> FFT_HD void dit_group(cf (&v)[1 << LOG_R], cf w0) {
  constexpr int R = 1 << LOG_R;
  cf wp[LOG_R];
  wp[0] = w0;
#pragma unroll
  for (int k = 1; k < LOG_R; ++k) wp[k] = cmul(wp[k - 1], wp[k - 1]);
#pragma unroll
  for (int k = LOG_R - 1; k >= 0; --k) {
    const int half = R >> (k + 1);
#pragma unroll
    for (int m = 0; m < R; ++m) {
      if ((m & half) == 0) {
        const int mm = m & (half - 1);
        cf B = rot16(v[m + half], 16 - (mm << k) * (16 / R));
        if (!UNIT) B = cmulc(B, wp[k]);
        const cf A = v[m];
        v[m] = A + B;
        if (!(LOWONLY && k == 0)) v[m + half] = A - B;
      }
    }
  }
}
template <int S> FFT_HD constexpr int goff(int m) { return S >= 16 ? m * S + m * (S / 16) : m * S + ((m * S) >> 4); }
template <bool INV, int LC, class P> FFT_HD void fft_pass8(P a, int NTOT, int tid, int nthr) {
  constexpr int S = LC >> 3;
  static_assert(S >= 8, "fft_pass8: S >= 8");
  for (int g = tid; g < (NTOT >> 3); g += nthr) {
    const int blk = g / S, j = g - blk * S, pb = fpad(blk * LC + j);
    cf v[8];
#pragma unroll
    for (int m = 0; m < 8; ++m) v[m] = a[pb + goff<S>(m)];
    const cf w0 = twid((float)j * (1.0f / (float)LC));
    if (INV) dit_group<3, false, false>(v, w0); else dif_group<3, false, false>(v, w0);
#pragma unroll
    for (int m = 0; m < 8; ++m) a[pb + goff<S>(m)] = v[m];
  }
}
constexpr int DM = 1024, T_ALL = 36864, NGRP = 9, DFF = 2816;
constexpr size_t MiB = 1u << 20;
constexpr size_t WS_MODS = 64 * 1024;
constexpr size_t WS_ROPE = 1008 * 1024;
constexpr size_t WS_HDN2 = 1 * MiB;
constexpr size_t WS_W1 = 4 * MiB, WS_W2 = 10 * MiB, WS_WGU = 12 * MiB, WS_WDN = 23 * MiB;
constexpr size_t WS_H = 29 * MiB;
constexpr size_t WS_BIG = 101 * MiB;
constexpr size_t WS_Q = WS_BIG, WS_K = WS_BIG + 72 * MiB, WS_V = WS_K + 80 * MiB, WS_O1 = WS_V + 80 * MiB;
constexpr size_t WS_U = WS_BIG, WS_VXT = WS_BIG + 216 * MiB;
constexpr size_t WS_ACT = WS_BIG;
constexpr size_t WS_X16 = WS_BIG + 304 * MiB;
constexpr size_t WS_FILT = WS_X16 + 72 * MiB;
constexpr size_t WS_END = WS_FILT + 34 * MiB;
static_assert(WS_END <= 512 * MiB && WS_O1 + 72 * MiB <= WS_X16 && WS_VXT + 72 * MiB <= WS_X16, "ws map");
constexpr int LDS_BYTES = 147456;

typedef unsigned short bf16_t;
typedef float f32x4 __attribute__((ext_vector_type(4)));
typedef unsigned u32x4 __attribute__((ext_vector_type(4)));
typedef unsigned u32x2 __attribute__((ext_vector_type(2)));

struct Params { const float* in[31]; float* out; unsigned char* ws; };
typedef const __attribute__((address_space(4))) unsigned char* kargp_t;
__device__ __forceinline__ unsigned long long karg_u64(int i) {
    const volatile __attribute__((address_space(4))) unsigned* k = (const volatile __attribute__((address_space(4))) unsigned*)__builtin_amdgcn_kernarg_segment_ptr();
    const unsigned lo = __builtin_amdgcn_readfirstlane(k[2 * i]), hi = __builtin_amdgcn_readfirstlane(k[2 * i + 1]);
    return ((unsigned long long)hi << 32) | lo; }
#define GAS1 __attribute__((address_space(1)))
__device__ __forceinline__ const float* INP(int i) { return (const float*)(const GAS1 float*)karg_u64(i); }
__device__ __forceinline__ float* OUTP() { return (float*)(GAS1 float*)karg_u64(31); }
__device__ __forceinline__ unsigned char* WSP() { return (unsigned char*)(GAS1 unsigned char*)karg_u64(32); }
enum { I_XP = 0, I_XS, I_CK, I_CV, I_C, I_CCTX, I_ADAW, I_ADAB, I_N1G, I_N2G, I_WQKV, I_LAM, I_SUBG, I_WO, I_HWIN, I_HBIN, I_HCW, I_HCB,
       I_FW1, I_FB1, I_FW2, I_FB2, I_FW3, I_FB3, I_FFREQ, I_SKIP, I_HWOUT, I_HBOUT, I_WGU, I_WDN, I_FING };

__device__ __forceinline__ unsigned f2bf(float f) { unsigned u = __builtin_bit_cast(unsigned, f); return (u + 0x7fffu + ((u >> 16) & 1u)) >> 16; }
__device__ __forceinline__ unsigned pk2(float lo, float hi) { return f2bf(lo) | (f2bf(hi) << 16); }
__device__ __forceinline__ float bf2f(unsigned short b) { return __builtin_bit_cast(float, (unsigned)b << 16); }
__device__ __forceinline__ float bflo(unsigned w) { return __builtin_bit_cast(float, w << 16); }
__device__ __forceinline__ float bfhi(unsigned w) { return __builtin_bit_cast(float, w & 0xffff0000u); }
template <class T> __device__ __forceinline__ T ldnt(const T* p) { return __builtin_nontemporal_load(p); }
__device__ __forceinline__ float wave_sum(float v) {
#pragma unroll
    for (int o = 1; o < 64; o <<= 1) v += __shfl_xor(v, o);
    return v;
}

__device__ __forceinline__ void transpose_item(const float* W, int K, int N, bf16_t* WT, float* scr, int item, int lane, int mode) {
    const int nblk = N / 32, kb = item / nblk, nb = item % nblk, k0 = 64 * kb, n0 = 32 * nb;
    int n0p = n0;
    if (mode == 1) { const int part = n0 >= DFF ? 1 : 0, jj = n0 - part * DFF; n0p = 256 * (jj >> 7) + 128 * part + (jj & 127); }
#pragma unroll 8
    for (int i = 0; i < 32; ++i) { const int kk = 2 * i + (lane >> 5); scr[kk * 33 + (lane & 31)] = ldnt(W + (size_t)(k0 + kk) * N + n0 + (lane & 31)); }
    __builtin_amdgcn_s_waitcnt(0); asm volatile("" ::: "memory");
    const int c = lane & 7;
#pragma unroll
    for (int j = 0; j < 4; ++j) { const int n = (lane >> 3) + 8 * j; const float* s = scr + (8 * c) * 33 + n;
        u32x4 o; o.x = pk2(s[0 * 33], s[1 * 33]); o.y = pk2(s[2 * 33], s[3 * 33]); o.z = pk2(s[4 * 33], s[5 * 33]); o.w = pk2(s[6 * 33], s[7 * 33]);
        *(u32x4*)(WT + (size_t)(n0p + n) * K + k0 + 8 * c) = o; }
    __builtin_amdgcn_s_waitcnt(0); asm volatile("" ::: "memory");
}
__device__ __forceinline__ void phase_convert_weights(int layer, unsigned char* lds, int which, int bidx, int nblk) {
    const int wid = tidx() >> 6, lane = tidx() & 63;
    float* scr = (float*)(lds + wid * 16384);
    const int gw = bidx * 8 + wid, NGW = nblk * 8;
    const int j = layer >> 1; const bool hy = layer & 1;
    const float* w1 = hy ? INP(I_HWIN) + (size_t)j * 1024 * 3072 : INP(I_WQKV) + (size_t)j * 1024 * 3072;
    const float* w2 = hy ? INP(I_HWOUT) + (size_t)j * 1024 * 1024 : INP(I_WO) + (size_t)j * 1024 * 1024;
    const float* wgu = INP(I_WGU) + (size_t)layer * 1024 * 5632;
    const float* wdn = INP(I_WDN) + (size_t)layer * 2816 * 1024;
    constexpr int I1 = 16 * 96, I2 = 16 * 32, I3 = 16 * 176, I4 = 44 * 32;
    const int lo = which == 2 ? I1 + I2 + I3 : 0, hi = which == 1 ? I1 + I2 + I3 : I1 + I2 + I3 + I4;
    for (int it = lo + gw; it < hi; it += NGW) {
        int r = it;
        if (r < I1) { transpose_item(w1, 1024, 3072, (bf16_t*)(WSP() + WS_W1), scr, r, lane, 0); continue; } r -= I1;
        if (r < I2) { transpose_item(w2, 1024, 1024, (bf16_t*)(WSP() + WS_W2), scr, r, lane, 0); continue; } r -= I2;
        if (r < I3) { transpose_item(wgu, 1024, 5632, (bf16_t*)(WSP() + WS_WGU), scr, r, lane, 1); continue; } r -= I3;
        transpose_item(wdn, 2816, 1024, (bf16_t*)(WSP() + WS_WDN), scr, r, lane, 0);
    }
}

__device__ __forceinline__ void phase0(unsigned char* lds) {
    const int tid = tidx(), wid = tid >> 6, lane = tid & 63;
    {
        float* sc = (float*)lds;
        float* red = (float*)(lds + 9 * 1024 * 4);
        if ((int)blockIdx.x < 192) {
            for (int e = tid; e < 9 * 1024; e += 512) { const int g = e >> 10, k = e & 1023; const float x = g == 0 ? INP(I_CCTX)[k] : INP(I_C)[(g - 1) * 1024 + k];
                sc[e] = x / (1.0f + expf(-x)); }
            __syncthreads();
            for (int it = blockIdx.x; it < 192; it += gridDim.x) {
                const int i = it / 48, chunk = it % 48, cg4 = tid & 31, kl = tid >> 5;
                f32x4 acc[9];
#pragma unroll
                for (int g = 0; g < 9; ++g) acc[g] = (f32x4){0.f, 0.f, 0.f, 0.f};
                const float* wp = INP(I_ADAW) + (size_t)i * 1024 * 6144 + chunk * 128 + cg4 * 4;
                for (int k = kl; k < 1024; k += 16) { const f32x4 w = ldnt((const f32x4*)(wp + (size_t)k * 6144));
#pragma unroll
                    for (int g = 0; g < 9; ++g) acc[g] += w * sc[g * 1024 + k]; }
#pragma unroll
                for (int g = 0; g < 9; ++g) *(f32x4*)(red + (kl * 9 + g) * 128 + cg4 * 4) = acc[g];
                __syncthreads();
                for (int e = tid; e < 9 * 128; e += 512) { const int g = e >> 7, col = e & 127; float s = INP(I_ADAB)[i * 6144 + chunk * 128 + col];
#pragma unroll
                    for (int q = 0; q < 16; ++q) s += red[(q * 9 + g) * 128 + col];
                    ((float*)(WSP() + WS_MODS))[((size_t)i * 9 + g) * 6144 + chunk * 128 + col] = s; }
                __syncthreads();
            }
        }
    }
    {
        const int gw = blockIdx.x * 8 + wid, NGW = gridDim.x * 8;
        for (int idx = gw; idx < 2 * 4352; idx += NGW) {
            const int jh = idx / 4352, r = idx % 4352; const int L = r < 4096 ? 4096 : 256, pos = r < 4096 ? r : r - 4096;
            const float fpos = (float)pos;
            const float tt = fpos / (float)(L - 1);
            const float w = 6.283185307179586f * fpos / (float)L;
            float z;
            { const int bi = lane == 0 ? 0 : ((lane - 1) & 15); const float band = 1e-4f + (float)bi * ((15.0f - 1e-4f) / 15.0f); const float a = w * band;
              z = lane == 0 ? tt : (lane <= 16 ? cosf(a) : -sinf(a)); }
            const float* w1 = INP(I_FW1) + (size_t)jh * 33 * 64; const float* w2 = INP(I_FW2) + (size_t)jh * 64 * 64;
            const float fr = INP(I_FFREQ)[jh * 64 + lane];
            float a1 = INP(I_FB1)[jh * 64 + lane];
            for (int f = 0; f < 33; ++f) a1 += __shfl(z, f) * w1[f * 64 + lane];
            const float h1 = sinf(fr * a1);
            float a2 = INP(I_FB2)[jh * 64 + lane];
            for (int k = 0; k < 64; ++k) a2 += __shfl(h1, k) * w2[k * 64 + lane];
            ((float*)(WSP() + WS_HDN2))[(size_t)idx * 64 + lane] = sinf(fr * a2);
        }
    }
    if (blockIdx.x == gridDim.x - 1) {
        for (int e = tid; e < 1024; e += 512) { const int posi = e >> 4, f = e & 15; const float inv = powf(10000.0f, -(float)f / 16.0f); const float ang = (float)posi * inv;
            ((float*)(WSP() + WS_ROPE))[e] = cosf(ang); ((float*)(WSP() + WS_ROPE))[1024 + e] = sinf(ang); }
    }
}

__device__ __forceinline__ void phase_norm(const float* gamma, const float* mods_l, int shift_idx, bool first) {
    const int wid = tidx() >> 6, lane = tidx() & 63;
    const int gw = blockIdx.x * 8 + wid, NGW = gridDim.x * 8;
    bf16_t* H = (bf16_t*)(WSP() + WS_H);
    const float* xc = INP(I_XP); const float* xm = INP(I_XS); const bf16_t* X16 = (const bf16_t*)(WSP() + WS_X16);
    f32x4 gm[4];
#pragma unroll
    for (int j = 0; j < 4; ++j) gm[j] = *(const f32x4*)(gamma + 4 * lane + 256 * j);
    for (int row0 = gw; row0 < T_ALL; row0 += 2 * NGW) {
        f32x4 v[2][4]; float s[2];
#pragma unroll
        for (int q = 0; q < 2; ++q) { const int row = row0 + q * NGW; s[q] = 0.f;
            if (row < T_ALL) {
                if (first) { const f32x4* xr = (const f32x4*)(row < 4096 ? xc + (size_t)row * 1024 : xm + (size_t)(row - 4096) * 1024) + lane;
#pragma unroll
                    for (int j = 0; j < 4; ++j) v[q][j] = ldnt(xr + 64 * j); }
                else { const u32x2* xr = (const u32x2*)(X16 + (size_t)row * 1024) + lane;
#pragma unroll
                    for (int j = 0; j < 4; ++j) { const u32x2 w = ldnt(xr + 64 * j); v[q][j] = (f32x4){bflo(w.x), bfhi(w.x), bflo(w.y), bfhi(w.y)}; } }
#pragma unroll
                for (int j = 0; j < 4; ++j) s[q] += (v[q][j].x * v[q][j].x + v[q][j].y * v[q][j].y) + (v[q][j].z * v[q][j].z + v[q][j].w * v[q][j].w); } }
#pragma unroll
        for (int q = 0; q < 2; ++q) { const int row = row0 + q * NGW;
            if (row < T_ALL) {
                const float* mp = mods_l + (size_t)(row >> 12) * 6144;
                const float rstd = 1.0f / sqrtf(wave_sum(s[q]) * (1.0f / 1024.0f) + 1e-6f);
                u32x2* o = (u32x2*)(H + (size_t)row * 1024) + lane;
#pragma unroll
                for (int j = 0; j < 4; ++j) { const f32x4 sh = *(const f32x4*)(mp + shift_idx * 1024 + 4 * lane + 256 * j), scl = *(const f32x4*)(mp + (shift_idx + 1) * 1024 + 4 * lane + 256 * j);
                    const f32x4 y = v[q][j] * rstd * gm[j] * (scl + 1.0f) + sh;
                    u32x2 w; w.x = pk2(y.x, y.y); w.y = pk2(y.z, y.w); o[64 * j] = w; } } }
    }
}
__device__ __forceinline__ void phase_final_norm() {
    const int wid = tidx() >> 6, lane = tidx() & 63;
    const int gw = blockIdx.x * 8 + wid, NGW = gridDim.x * 8;
    const float* gamma = INP(I_FING); const bf16_t* X16 = (const bf16_t*)(WSP() + WS_X16);
    f32x4 gm[4];
#pragma unroll
    for (int j = 0; j < 4; ++j) gm[j] = *(const f32x4*)(gamma + 4 * lane + 256 * j);
    for (int row = gw; row < T_ALL; row += NGW) {
        const u32x2* xr = (const u32x2*)(X16 + (size_t)row * 1024) + lane;
        f32x4 v[4]; float s = 0.f;
#pragma unroll
        for (int j = 0; j < 4; ++j) { const u32x2 w = xr[64 * j]; v[j] = (f32x4){bflo(w.x), bfhi(w.x), bflo(w.y), bfhi(w.y)}; s += (v[j].x * v[j].x + v[j].y * v[j].y) + (v[j].z * v[j].z + v[j].w * v[j].w); }
        const float rstd = 1.0f / sqrtf(wave_sum(s) * (1.0f / 1024.0f) + 1e-6f);
        f32x4* o = (f32x4*)(OUTP() + (size_t)row * 1024) + lane;
#pragma unroll
        for (int j = 0; j < 4; ++j) __builtin_nontemporal_store(v[j] * rstd * gm[j], o + 64 * j);
    }
}
__device__ __forceinline__ void phase_cache_convert(int j) {
    bf16_t* Kb = (bf16_t*)(WSP() + WS_K); bf16_t* Vb = (bf16_t*)(WSP() + WS_V);
    const size_t n8 = (size_t)8 * 512 * 1024 / 8;
    for (size_t i = (size_t)blockIdx.x * 512 + tidx(); i < 2 * n8; i += (size_t)gridDim.x * 512) {
        const bool isv = i >= n8; const size_t e = (isv ? i - n8 : i) * 8; const int b = (int)(e / (512 * 1024)); const size_t rem = e % (512 * 1024);
        const float* src = (isv ? INP(I_CV) : INP(I_CK)) + ((size_t)(b * 2 + j) * 512 * 1024) + rem;
        const f32x4 a = ldnt((const f32x4*)src), c = ldnt((const f32x4*)(src + 4));
        u32x4 w; w.x = pk2(a.x, a.y); w.y = pk2(a.z, a.w); w.z = pk2(c.x, c.y); w.w = pk2(c.z, c.w);
        *(u32x4*)((isv ? Vb : Kb) + (size_t)(4096 + b * 4608) * 1024 + rem) = w;
    }
}
struct AttnUnits {
    int vcu, G;
    __device__ __forceinline__ bool get(int i, attn::AUnit& u) const {
        const int id = vcu + i * G; if (id >= 2048 + 256) return false;
        int b, h, mp; size_t qrow, krow;
        if (id < 2048) { const int bh = id >> 5, r = id & 31; b = bh >> 3; h = bh & 7; mp = r >> 4; const int qb = r & 15; u.seq = 4608;
            qrow = (size_t)4096 + (size_t)b * 4096 + qb * 256; krow = (size_t)4096 + (size_t)b * 4608; }
        else { const int r = id - 2048; b = r >> 4; h = (r >> 1) & 7; mp = r & 1; u.seq = 256; qrow = (size_t)b * 256; krow = qrow; }
        unsigned char* ws = WSP();
        u.Q = (const attn::bf16*)(ws + WS_Q) + qrow * 1024 + h * 128 + mp * 64; u.K = (const attn::bf16*)(ws + WS_K) + krow * 1024 + h * 128 + mp * 64; u.V = (const attn::bf16*)(ws + WS_V) + krow * 1024 + h * 128;
        u.O = (attn::bf16*)(ws + (mp ? WS_O1 : WS_H)) + qrow * 1024 + h * 128; return true;
    }
};
__device__ __forceinline__ void phase_attention(unsigned char* lds) {
    const int G = gridDim.x, bx = blockIdx.x; const int vcu = (G % 8 == 0) ? (bx % 8) * (G / 8) + bx / 8 : bx;
    AttnUnits U{vcu, G};
    attn::attn_run(U, (char*)lds);
}
__device__ __forceinline__ void phase_combine(int layer) {
    const int wid = tidx() >> 6, lane = tidx() & 63;
    const int gw = blockIdx.x * 8 + wid, NGW = gridDim.x * 8;
    const int j = layer >> 1;
    const float* lp = INP(I_LAM) + (size_t)j * 4 * 64;
    const float s1 = wave_sum(lp[lane] * lp[64 + lane]), s2 = wave_sum(lp[128 + lane] * lp[192 + lane]);
    const float lam_init = 0.8f - 0.6f * expf(-0.3f * (float)layer);
    const float lam = expf(s1) - expf(s2) + lam_init;
    const float osc = 1.0f - lam_init;
    bf16_t* O0 = (bf16_t*)(WSP() + WS_H); const bf16_t* O1 = (const bf16_t*)(WSP() + WS_O1);
    float gsub[16];
#pragma unroll
    for (int e = 0; e < 16; ++e) gsub[e] = INP(I_SUBG)[j * 128 + (lane & 7) * 16 + e] * osc;
    for (int row = gw; row < T_ALL; row += NGW) {
        u32x4* a = (u32x4*)(O0 + (size_t)row * 1024) + lane * 2; const u32x4* c = (const u32x4*)(O1 + (size_t)row * 1024) + lane * 2;
        const u32x4 a0 = ldnt((const u32x4*)a), a1 = ldnt((const u32x4*)a + 1), c0 = ldnt(c), c1 = ldnt(c + 1);
        float v[16];
#pragma unroll
        for (int q = 0; q < 4; ++q) { v[2 * q] = bflo(a0[q]) - lam * bflo(c0[q]); v[2 * q + 1] = bfhi(a0[q]) - lam * bfhi(c0[q]);
            v[8 + 2 * q] = bflo(a1[q]) - lam * bflo(c1[q]); v[8 + 2 * q + 1] = bfhi(a1[q]) - lam * bfhi(c1[q]); }
        float s = 0.f;
#pragma unroll
        for (int e = 0; e < 16; ++e) s += v[e] * v[e];
        s += __shfl_xor(s, 1); s += __shfl_xor(s, 2); s += __shfl_xor(s, 4);
        const float rstd = 1.0f / sqrtf(s * (1.0f / 128.0f) + 1e-5f);
        u32x4 w0, w1;
#pragma unroll
        for (int q = 0; q < 4; ++q) { w0[q] = pk2(v[2 * q] * rstd * gsub[2 * q], v[2 * q + 1] * rstd * gsub[2 * q + 1]);
            w1[q] = pk2(v[8 + 2 * q] * rstd * gsub[8 + 2 * q], v[8 + 2 * q + 1] * rstd * gsub[8 + 2 * q + 1]); }
        a[0] = w0; a[1] = w1;
    }
}
__device__ __forceinline__ size_t vxt_index(int row, int c) {
    return row < 4096 ? ((size_t)((row >> 8) * 1024 + c) * 256 + (row & 255)) : ((size_t)4096 * 1024 + ((size_t)(((row - 4096) >> 12) * 1024 + c) * 4096) + (row & 4095));
}
__device__ __forceinline__ void unpack8(const u32x4 w, float* f) {
#pragma unroll
    for (int q = 0; q < 4; ++q) { f[2 * q] = bflo(w[q]); f[2 * q + 1] = bfhi(w[q]); }
}
__device__ __forceinline__ void phase_conv3(int jh, unsigned char* lds) {
    const int tid = tidx();
    const bf16_t* U = (const bf16_t*)(WSP() + WS_U); bf16_t* X0 = (bf16_t*)(WSP() + WS_H); bf16_t* VXT = (bf16_t*)(WSP() + WS_VXT);
    float* tile = (float*)lds;
    const float* cw = INP(I_HCW) + (size_t)jh * 3 * 3072; const float* cb = INP(I_HCB) + (size_t)jh * 3072;
    const int tl = tid >> 3, c8 = (tid & 7) * 8;
    for (int it = blockIdx.x; it < 576 * 8; it += gridDim.x) {
        const int tt = it >> 3, ct = it & 7; const int row = tt * 64 + tl;
        const int L = row < 4096 ? 256 : 4096; const int ts = row & (L - 1);
        const bool hasp = ts > 0, hasn = ts < L - 1;
        u32x4 uc[2][3], um[2][3], un[2][3];
#pragma unroll
        for (int hf = 0; hf < 2; ++hf)
#pragma unroll
            for (int part = 1; part < 3; ++part) {
                const bf16_t* up = U + (size_t)row * 3072 + part * 1024 + ct * 128 + hf * 64 + c8;
                uc[hf][part] = ldnt((const u32x4*)up);
                um[hf][part] = hasp ? ldnt((const u32x4*)(up - 3072)) : (u32x4){0u, 0u, 0u, 0u};
                un[hf][part] = hasn ? ldnt((const u32x4*)(up + 3072)) : (u32x4){0u, 0u, 0u, 0u};
            }
#pragma unroll
        for (int hf = 0; hf < 2; ++hf) {
            const int c0 = ct * 128 + hf * 64 + c8;
            float res[3][8];
#pragma unroll
            for (int part = 1; part < 3; ++part) {
                const int col = part * 1024 + c0;
                float fm[8], fc[8], fn[8]; unpack8(um[hf][part], fm); unpack8(uc[hf][part], fc); unpack8(un[hf][part], fn);
#pragma unroll
                for (int e = 0; e < 8; ++e) res[part][e] = fm[e] * cw[col + e] + fc[e] * cw[3072 + col + e] + fn[e] * cw[6144 + col + e] + cb[col + e];
            }
#pragma unroll
            for (int e = 0; e < 8; ++e) tile[(hf * 64 + c8 + e) * 65 + tl] = res[2][e] * res[1][e];
        }
        __syncthreads();
#pragma unroll
        for (int hf = 0; hf < 2; ++hf) { const int cl = hf * 64 + (tid >> 3), t8 = (tid & 7) * 8; const int r0 = tt * 64 + t8, c = ct * 128 + cl;
          f32x4 a, b; a.x = tile[cl * 65 + t8]; a.y = tile[cl * 65 + t8 + 1]; a.z = tile[cl * 65 + t8 + 2]; a.w = tile[cl * 65 + t8 + 3];
          b.x = tile[cl * 65 + t8 + 4]; b.y = tile[cl * 65 + t8 + 5]; b.z = tile[cl * 65 + t8 + 6]; b.w = tile[cl * 65 + t8 + 7];
          u32x4 w; w.x = pk2(a.x, a.y); w.y = pk2(a.z, a.w); w.z = pk2(b.x, b.y); w.w = pk2(b.z, b.w); *(u32x4*)(VXT + vxt_index(r0, c)) = w; }
        __syncthreads();
    }
}
__device__ __forceinline__ void phase_gate(int jh, unsigned char* lds) {
    const int tid = tidx();
    bf16_t* Z = (bf16_t*)(WSP() + WS_H); const bf16_t* VXT = (const bf16_t*)(WSP() + WS_VXT); const bf16_t* U = (const bf16_t*)(WSP() + WS_U);
    const float* cw = INP(I_HCW) + (size_t)jh * 3 * 3072; const float* cb = INP(I_HCB) + (size_t)jh * 3072;
    float* tile = (float*)lds;
    for (int it = blockIdx.x; it < 576 * 8; it += gridDim.x) {
        const int tt = it >> 3, ct = it & 7;
        const int tl = tid >> 3, c8 = (tid & 7) * 8; const int row = tt * 64 + tl;
        const int L = row < 4096 ? 256 : 4096; const int ts = row & (L - 1);
        const bool hasp = ts > 0, hasn = ts < L - 1;
        f32x4 ya[2], yb[2]; u32x4 uc[2], um[2], un[2];
#pragma unroll
        for (int hf = 0; hf < 2; ++hf) { const int cl = hf * 64 + (tid >> 3), t8 = (tid & 7) * 8; const int r0 = tt * 64 + t8, c = ct * 128 + cl;
          const u32x4 w = ldnt((const u32x4*)(VXT + vxt_index(r0, c))); ya[hf] = (f32x4){bflo(w.x), bfhi(w.x), bflo(w.y), bfhi(w.y)}; yb[hf] = (f32x4){bflo(w.z), bfhi(w.z), bflo(w.w), bfhi(w.w)}; }
#pragma unroll
        for (int hf = 0; hf < 2; ++hf) { const bf16_t* up = U + (size_t)row * 3072 + ct * 128 + hf * 64 + c8;
          uc[hf] = ldnt((const u32x4*)up); um[hf] = hasp ? ldnt((const u32x4*)(up - 3072)) : (u32x4){0u, 0u, 0u, 0u}; un[hf] = hasn ? ldnt((const u32x4*)(up + 3072)) : (u32x4){0u, 0u, 0u, 0u}; }
#pragma unroll
        for (int hf = 0; hf < 2; ++hf) { const int cl = hf * 64 + (tid >> 3), t8 = (tid & 7) * 8;
          tile[(t8 + 0) * 129 + cl] = ya[hf].x; tile[(t8 + 1) * 129 + cl] = ya[hf].y; tile[(t8 + 2) * 129 + cl] = ya[hf].z; tile[(t8 + 3) * 129 + cl] = ya[hf].w;
          tile[(t8 + 4) * 129 + cl] = yb[hf].x; tile[(t8 + 5) * 129 + cl] = yb[hf].y; tile[(t8 + 6) * 129 + cl] = yb[hf].z; tile[(t8 + 7) * 129 + cl] = yb[hf].w; }
        __syncthreads();
#pragma unroll
        for (int hf = 0; hf < 2; ++hf) { const int cc = hf * 64 + c8, col = ct * 128 + cc;
          float fm[8], fc[8], fn[8]; unpack8(um[hf], fm); unpack8(uc[hf], fc); unpack8(un[hf], fn);
          float r[8];
#pragma unroll
          for (int e = 0; e < 8; ++e) { const float x0 = fm[e] * cw[col + e] + fc[e] * cw[3072 + col + e] + fn[e] * cw[6144 + col + e] + cb[col + e]; r[e] = x0 * tile[tl * 129 + cc + e]; }
          u32x4 w; w.x = pk2(r[0], r[1]); w.y = pk2(r[2], r[3]); w.z = pk2(r[4], r[5]); w.w = pk2(r[6], r[7]); *(u32x4*)(Z + (size_t)row * 1024 + col) = w; }
        __syncthreads();
    }
}
__device__ __forceinline__ void phase_filter(int jh, unsigned char* lds, int bidx, int nblk) {
    const int tid = tidx(), lx = tid & 63, cgp = tid >> 6;
    float* hs = (float*)lds;
    float* w3s = (float*)(lds + 64 * 65 * 4);
    const float* tab = (const float*)(WSP() + WS_HDN2) + (size_t)jh * 4352 * 64;
    const float* w3 = INP(I_FW3) + (size_t)jh * 64 * 2048; const float* b3 = INP(I_FB3) + jh * 2048;
    float* hT = (float*)(WSP() + WS_FILT);
    __syncthreads();
    for (int it = bidx; it < 68 * 8; it += nblk) {
        const int lt = it >> 3, ctile = it & 7; const int l0 = lt * 64, col0 = ctile * 256;
        for (int e = tid; e < 64 * 64; e += 512) hs[(e >> 6) * 65 + (e & 63)] = tab[(size_t)l0 * 64 + e];
        for (int e = tid; e < 64 * 256; e += 512) w3s[e] = w3[(size_t)(e >> 8) * 2048 + col0 + (e & 255)];
        __syncthreads();
        float acc[32];
#pragma unroll
        for (int q = 0; q < 32; ++q) acc[q] = 0.f;
#pragma unroll 4
        for (int k = 0; k < 64; ++k) { const float hv = hs[lx * 65 + k]; const f32x4* wr = (const f32x4*)(w3s + k * 256 + cgp * 32);
#pragma unroll
            for (int q = 0; q < 8; ++q) { const f32x4 w = wr[q]; acc[4 * q] += hv * w.x; acc[4 * q + 1] += hv * w.y; acc[4 * q + 2] += hv * w.z; acc[4 * q + 3] += hv * w.w; } }
        const int r = l0 + lx; const int L = r < 4096 ? 4096 : 256, pos = r < 4096 ? r : r - 4096;
        const float tl = (float)pos / (float)(L - 1);
        float* ob = r < 4096 ? hT : hT + (size_t)1024 * 2 * 4096;
#pragma unroll
        for (int q = 0; q < 32; ++q) { const int col = col0 + cgp * 32 + q, dir = col >> 10, c = col & 1023;
            const float delta = fabsf(-3.0701134573253945f + (-15.350567286626973f + 3.0701134573253945f) * ((float)c / 1023.0f));
            ob[(size_t)(c * 2 + dir) * L + pos] = (acc[q] + b3[col]) * expf(-tl * delta); }
        __syncthreads();
    }
}
template <bool INV, int LOG_N> __device__ __forceinline__ void fft_mid(cf* a, int NTOT, int tid) {
    if constexpr (LOG_N == 13) {
        if (!INV) { fft_pass8<false, 1024>(a, NTOT, tid, 512); __syncthreads(); fft_pass8<false, 128>(a, NTOT, tid, 512); __syncthreads(); }
        else { fft_pass8<true, 128>(a, NTOT, tid, 512); __syncthreads(); fft_pass8<true, 1024>(a, NTOT, tid, 512); __syncthreads(); }
    } else { fft_pass8<INV, 64>(a, NTOT, tid, 512); __syncthreads(); }
}
template <int LOG_N>
__device__ __forceinline__ void hyena_fft_unit(int jh, int c, unsigned char* lds, bool dry) {
    constexpr int N = 1 << LOG_N, L = N / 2, LOG_L = LOG_N - 1, LOG_LAST = (LOG_N % 3 == 1) ? 4 : 3, RL = 1 << LOG_LAST, S0 = N / 8;
    constexpr int NAR = (LOG_N == 13) ? 2 : 8, NRND = (LOG_N == 13) ? 2 : 1, NTOT = NAR * N;
    const int tid = tidx();
    cf* a = (cf*)lds;
    float* wl = (float*)(lds + 139264);
    bf16_t* vbase = (bf16_t*)(WSP() + WS_VXT) + (LOG_N == 13 ? (size_t)4096 * 1024 : 0);
    const float* hT = (const float*)(WSP() + WS_FILT) + (LOG_N == 13 ? (size_t)0 : (size_t)1024 * 2 * 4096) + (size_t)c * 2 * L;
    float asum = 0.f;
#pragma unroll 4
    for (int i = tid; i < N; i += 512) {
        const float hv = i < L ? hT[i] : hT[L + (i == L ? 0 : N - i)];
        asum += fabsf(hv);
        a[fpad(i)] = cf{i == L ? 0.f : hv, 0.f};
    }
    asum = wave_sum(asum);
    if ((tid & 63) == 0) wl[136 + (tid >> 6)] = asum;
    __syncthreads();
    float tot = 0.f;
#pragma unroll
    for (int q = 0; q < 8; ++q) tot += wl[136 + q];
    const float fs = 1.0f / ((tot + 1e-6f) * (float)N);
    fft_pass8<false, N>(a, N, tid, 512); __syncthreads();
    fft_mid<false, LOG_N>(a, N, tid);
    cf kreg[RL];
    { const int pb = fpad((tid % (N >> LOG_LAST)) * RL);
#pragma unroll
      for (int e = 0; e < RL; ++e) kreg[e] = a[pb + e];
      dif_group<LOG_LAST, true, false>(kreg, cf{1.f, 0.f}); }
    __syncthreads();
    const float skipc = INP(I_SKIP)[jh * 1024 + c];
#pragma unroll 1
    for (int rd = 0; rd < NRND; ++rd) {
        for (int g = tid; g < NTOT / 8; g += 512) {
            const int arr = g / S0, j = g - arr * S0; const int sq = 2 * (rd * NAR + arr);
            const bf16_t* p0 = vbase + (((size_t)sq * 1024 + c) << LOG_L) + j; const bf16_t* p1 = p0 + ((size_t)1024 << LOG_L);
            cf x[8];
#pragma unroll
            for (int m = 0; m < 4; ++m) x[m] = cf{bf2f(p0[m * S0]), bf2f(p1[m * S0])};
#pragma unroll
            for (int m = 4; m < 8; ++m) x[m] = cf{0.f, 0.f};
            dif_group<3, false, true>(x, twid((float)j * (1.0f / (float)N)));
            const int pb = fpad(arr * N + j);
#pragma unroll
            for (int m = 0; m < 8; ++m) a[pb + goff<S0>(m)] = x[m];
        }
        __syncthreads();
        fft_mid<false, LOG_N>(a, NTOT, tid);
        for (int g = tid; g < (NTOT >> LOG_LAST); g += 512) {
            cf x[RL]; const int pb = fpad(g << LOG_LAST);
#pragma unroll
            for (int e = 0; e < RL; ++e) x[e] = a[pb + e];
            dif_group<LOG_LAST, true, false>(x, cf{1.f, 0.f});
#pragma unroll
            for (int e = 0; e < RL; ++e) x[e] = cmul(x[e], kreg[e]);
            dit_group<LOG_LAST, true, false>(x, cf{1.f, 0.f});
#pragma unroll
            for (int e = 0; e < RL; ++e) a[pb + e] = x[e];
        }
        __syncthreads();
        fft_mid<true, LOG_N>(a, NTOT, tid);
        for (int g = tid; g < NTOT / 8; g += 512) {
            const int arr = g / S0, j = g - arr * S0; const int sq = 2 * (rd * NAR + arr);
            bf16_t* p0 = vbase + (((size_t)sq * 1024 + c) << LOG_L) + j; bf16_t* p1 = p0 + ((size_t)1024 << LOG_L);
            cf x[8]; const int pb = fpad(arr * N + j);
#pragma unroll
            for (int m = 0; m < 8; ++m) x[m] = a[pb + goff<S0>(m)];
            dit_group<3, false, true>(x, twid((float)j * (1.0f / (float)N)));
#pragma unroll
            for (int m = 0; m < 4; ++m) { const float v0 = bf2f(p0[m * S0]), v1 = bf2f(p1[m * S0]); const float y0 = x[m].x * fs + v0 * skipc, y1 = x[m].y * fs + v1 * skipc; if (!dry || y0 == 1.2345e30f) { p0[m * S0] = (bf16_t)f2bf(y0); p1[m * S0] = (bf16_t)f2bf(y1); } }
        }
        __syncthreads();
    }
}
__device__ __forceinline__ void phase_fft(int jh, unsigned char* lds, bool dry) {
    for (int it = blockIdx.x; it < 2048; it += gridDim.x) {
        if (it < 1024) hyena_fft_unit<13>(jh, it, lds, dry); else hyena_fft_unit<9>(jh, it - 1024, lds, dry);
    }
}
#define LAS __attribute__((address_space(3)))
#define XB_TMO      128
#define XB_XCNT(j)  (256  + 64 * (j))
#define XB_XSUB(j)  (1280 + 64 * (j))
#define XB_XGEN(j)  (2304 + 64 * (j))
#define XB_TOP      3328
#define XB_TOPGEN   3392
#define XCD_BAR_WORDS 3456
#define XB_SPIN_CAP (1u << 18)

__device__ __forceinline__ unsigned xb_ld(unsigned* p)              { return __hip_atomic_load(p, __ATOMIC_RELAXED, __HIP_MEMORY_SCOPE_AGENT); }
__device__ __forceinline__ unsigned xb_add(unsigned* p, unsigned v) { return __hip_atomic_fetch_add(p, v, __ATOMIC_RELAXED, __HIP_MEMORY_SCOPE_AGENT); }
__device__ __forceinline__ unsigned xb_xcc_id() { return (unsigned)__builtin_amdgcn_s_getreg((3 << 11) | 20) & 0xFu; }
#define XB_SPIN(cond, bar) do { unsigned _sp = 0; while (cond) { __builtin_amdgcn_s_sleep(1); \
    if ((++_sp & 255u) == 0u) { if (xb_ld(&(bar)[XB_TMO])) break; if (_sp > XB_SPIN_CAP) { atomicAdd(&(bar)[XB_TMO], 1u); break; } } } } while (0)

struct XcdBarrier {
    unsigned* bar; unsigned x;
    volatile LAS unsigned* st;
};

__device__ __forceinline__ XcdBarrier xcd_barrier_post(unsigned* bar, volatile LAS unsigned* st) {
    XcdBarrier b; b.bar = bar; b.x = xb_xcc_id(); b.st = st;
    if (threadIdx.x == 0) (void)xb_add(&bar[XB_XCNT(b.x)], 1u);
    return b;
}
__device__ __forceinline__ void xcd_barrier_complete(unsigned* bar, unsigned x, unsigned& nloc, unsigned& nx) {
    const unsigned G = gridDim.x * gridDim.y * gridDim.z;
    unsigned sum, cnt, mine, sp = 0u;
    for (;;) {
        sum = 0u; cnt = 0u; mine = 0u;
#pragma unroll
        for (unsigned j = 0; j < 16; ++j) { const unsigned c = xb_ld(&bar[XB_XCNT(j)]); sum += c; cnt += (c > 0u) ? 1u : 0u; mine = (j == x) ? c : mine; }
        if (sum == G) break;
        __builtin_amdgcn_s_sleep(1);
        if ((++sp & 255u) == 0u) { if (xb_ld(&bar[XB_TMO])) break; if (sp > XB_SPIN_CAP) { atomicAdd(&bar[XB_TMO], 1u); break; } }
    }
    nloc = mine > 0u ? mine : 1u; nx = cnt > 0u ? cnt : 1u;
}

__device__ __forceinline__ void xcd_barrier(const XcdBarrier& b) {
    asm volatile("s_waitcnt vmcnt(0)" ::: "memory");
    __syncthreads();
    if (threadIdx.x == 0) {
        unsigned* bar = b.bar;
        __builtin_amdgcn_s_waitcnt(0);
        unsigned nloc = b.st[0], nx = b.st[1];
        if (nloc == 0u) { xcd_barrier_complete(bar, b.x, nloc, nx); b.st[0] = nloc; b.st[1] = nx; }
        const unsigned old = xb_add(&bar[XB_XSUB(b.x)], 1u);
        const unsigned gen = old / nloc;
        if (old + 1u == (gen + 1u) * nloc) {
            __builtin_amdgcn_fence(__ATOMIC_RELEASE, "agent");
            asm volatile("s_waitcnt vmcnt(0)" ::: "memory");
            const unsigned og = xb_add(&bar[XB_TOP], 1u);
            const unsigned tg = og / nx;
            if (og + 1u == (tg + 1u) * nx) xb_add(&bar[XB_TOPGEN], 1u);
            else XB_SPIN(xb_ld(&bar[XB_TOPGEN]) == tg, bar);
            __builtin_amdgcn_fence(__ATOMIC_ACQUIRE, "agent");
            xb_add(&bar[XB_XGEN(b.x)], 1u);
            asm volatile("s_waitcnt vmcnt(0)" ::: "memory");
        } else {
            XB_SPIN(xb_ld(&bar[XB_XGEN(b.x)]) == gen, bar);
            __builtin_amdgcn_fence(__ATOMIC_ACQUIRE, "agent");
            asm volatile("s_waitcnt vmcnt(0)" ::: "memory");
        }
    }
    __syncthreads();
}
__global__ void __launch_bounds__(512, 2) fwd_megakernel(Params p) {
    extern __shared__ __attribute__((aligned(16))) unsigned char lds[];
    cg::grid_group grid = cg::this_grid();
    const int G = gridDim.x;
    { volatile LAS unsigned* st0 = (volatile LAS unsigned*)((LAS unsigned char*)lds + (LDS_BYTES - 64)); if (tidx() < 2) st0[tidx() & 1] = 0u;
      __syncthreads(); }
    (void)xcd_barrier_post((unsigned*)(WSP()), (volatile LAS unsigned*)((LAS unsigned char*)lds + (LDS_BYTES - 64)));
#define GSYNC() do { XcdBarrier b_; b_.bar = (unsigned*)(WSP()); b_.x = xb_xcc_id(); b_.st = (volatile LAS unsigned*)((LAS unsigned char*)lds + (LDS_BYTES - 64)); xcd_barrier(b_); } while (0)
#ifndef NO_P0
    phase0(lds);
#ifdef PROBE_P0
    __syncthreads(); phase0(lds); __syncthreads(); phase0(lds);
#endif
#endif
    if (gridDim.y == 0x7fffffffu) grid.sync();
    GSYNC();
#pragma unroll 1
    for (int s = 0; s < 8; ++s) {
        const int layer = s >> 1; const bool isffn = s & 1, ishy = layer & 1; const int j = layer >> 1;
        unsigned char* ws = WSP();
        const float* mods_l = (const float*)(ws + WS_MODS) + (size_t)layer * 9 * 6144;
        const bool early = (G == 256) && layer > 0;
        if (!isffn) { phase_convert_weights(layer, lds, early ? 2 : 0, (int)blockIdx.x, G); if (!ishy) phase_cache_convert(j); }
        if (!isffn && ishy && !early) phase_filter(j, lds, (int)blockIdx.x, G);
        phase_norm((isffn ? INP(I_N2G) : INP(I_N1G)) + layer * 1024, mods_l, isffn ? 3 : 0, s == 0);
        GSYNC();
        if (isffn) {
            pg8::Gemm g{(const pg8::bf16_t*)(ws + WS_H), (const pg8::bf16_t*)(ws + WS_WGU), T_ALL, 2 * DFF, 1024}; pg8::StaticOrder S; S.init(T_ALL, 2 * DFF, G, (int)blockIdx.x);
            pg8::EpiSwiglu E{(pg8::bf16_t*)(ws + WS_ACT)};
            #ifndef NO_G1
pg8::gemm_phase<pg8::EpiSwiglu, pg8::StaticOrder, true, true>((PG8_LAS unsigned char*)lds, g, S, E);
#ifdef PROBE_G1
            pg8::gemm_phase<pg8::EpiSwiglu, pg8::StaticOrder, true, true>((PG8_LAS unsigned char*)lds, g, S, E);
#endif
#endif
        } else if (ishy) {
            pg8::Gemm g{(const pg8::bf16_t*)(ws + WS_H), (const pg8::bf16_t*)(ws + WS_W1), T_ALL, 3072, 1024}; pg8::StaticOrder S; S.init(T_ALL, 3072, G, (int)blockIdx.x);
            pg8::EpiBf16 E{(pg8::bf16_t*)(ws + WS_U), 3072, INP(I_HBIN) + (size_t)j * 3072};
            #ifndef NO_G2
pg8::gemm_phase<pg8::EpiBf16, pg8::StaticOrder, true, true>((PG8_LAS unsigned char*)lds, g, S, E);
#ifdef PROBE_G1
            pg8::gemm_phase<pg8::EpiBf16, pg8::StaticOrder, true, true>((PG8_LAS unsigned char*)lds, g, S, E);
#endif
#endif
        } else {
            pg8::Gemm g{(const pg8::bf16_t*)(ws + WS_H), (const pg8::bf16_t*)(ws + WS_W1), T_ALL, 3072, 1024}; pg8::StaticOrder S; S.init(T_ALL, 3072, G, (int)blockIdx.x);
            float* ck = OUTP() + (size_t)T_ALL * 1024 + (size_t)j * 256 * 1024;
            static_assert(WS_K == WS_Q + (72u << 20) && WS_V == WS_Q + (152u << 20), "EpiQKV buffer spacing");
            pg8::EpiQKV E{ws + WS_Q, ck, (const float*)(ws + WS_ROPE), (const float*)(ws + WS_ROPE) + 1024};
            #ifndef NO_G3
pg8::gemm_phase<pg8::EpiQKV, pg8::StaticOrder, true, true>((PG8_LAS unsigned char*)lds, g, S, E);
#ifdef PROBE_G1
            pg8::gemm_phase<pg8::EpiQKV, pg8::StaticOrder, true, true>((PG8_LAS unsigned char*)lds, g, S, E);
#endif
#endif
        }
        GSYNC();
        if (!isffn) {
            if (ishy) { phase_conv3(j, lds); GSYNC();
#ifndef NO_FFT
#ifdef PROBE_FFT
phase_fft(j, lds, true); GSYNC();
#endif
phase_fft(j, lds, false);
#endif
 GSYNC(); phase_gate(j, lds); GSYNC(); }
            else {
#ifndef NO_ATT
phase_attention(lds);
#ifdef PROBE_ATT
 GSYNC(); phase_attention(lds);
#endif
#endif
 GSYNC(); phase_combine(layer); GSYNC(); }
        }
        {
            const pg8::bf16_t* A = isffn ? (const pg8::bf16_t*)(ws + WS_ACT) : (const pg8::bf16_t*)(ws + WS_H);
            const pg8::bf16_t* B = isffn ? (const pg8::bf16_t*)(ws + WS_WDN) : (const pg8::bf16_t*)(ws + WS_W2);
            const int K = isffn ? DFF : 1024;
            pg8::Gemm g{A, B, T_ALL, 1024, K}; pg8::StaticOrder S; S.init(T_ALL, 1024, G, (int)blockIdx.x);
            const float* bias = (!isffn && ishy) ? INP(I_HBOUT) + (size_t)j * 1024 : nullptr;
            pg8::EpiRes E{(pg8::bf16_t*)(ws + WS_X16), INP(I_XP), INP(I_XS), mods_l + (isffn ? 5 : 2) * 1024, bias, s == 0 ? 1 : 0};
            #ifndef NO_G4
pg8::gemm_phase<pg8::EpiRes, pg8::StaticOrder, true, true>((PG8_LAS unsigned char*)lds, g, S, E);
#endif
        }
        if (isffn && layer < 3 && G == 256 && blockIdx.x >= 64) {
            phase_convert_weights(layer + 1, lds, 1, (int)blockIdx.x - 64, 192);
            if ((layer + 1) & 1) phase_filter((layer + 1) >> 1, lds, (int)blockIdx.x - 64, 192);
        }
        GSYNC();
    }
#ifdef PROBE_SYNC
#pragma unroll 1
    for (int q = 0; q < 40; ++q) GSYNC();
#endif
    phase_final_norm();
}

extern "C" void kernel_launch(void* const* d_in, const int* in_sizes, int n_in, void* d_out, int out_size, void* d_ws, size_t ws_size, hipStream_t stream) {
    static int grid_blocks = 0;
    if (grid_blocks == 0) {
        if (n_in != 31 || ws_size < WS_END) { fprintf(stderr, "kernel_launch: unexpected n_in %d or ws_size %zu (need %zu)\n", n_in, ws_size, (size_t)WS_END); grid_blocks = -1; return; }
        int dev = 0, cus = 0, per_cu = 0;
        hipGetDevice(&dev);
        hipDeviceGetAttribute(&cus, hipDeviceAttributeMultiprocessorCount, dev);
        if (hipFuncSetAttribute((const void*)fwd_megakernel, hipFuncAttributeMaxDynamicSharedMemorySize, LDS_BYTES) != hipSuccess) { fprintf(stderr, "kernel_launch: hipFuncSetAttribute failed\n"); grid_blocks = -1; return; }
        if (hipOccupancyMaxActiveBlocksPerMultiprocessor(&per_cu, (const void*)fwd_megakernel, 512, LDS_BYTES) != hipSuccess || per_cu < 1) { fprintf(stderr, "kernel_launch: occupancy query says %d\n", per_cu); per_cu = 1; }
        (void)hipGetLastError();
        grid_blocks = cus * 1;
        fprintf(stderr, "kernel_launch: cus %d per_cu %d grid %d ws %zu\n", cus, per_cu, grid_blocks, ws_size);
    }
    if (grid_blocks < 0) return;
    if (hipMemsetAsync(d_ws, 0, 16384, stream) != hipSuccess) { fprintf(stderr, "kernel_launch: hipMemsetAsync of the barrier words failed\n"); return; }
    Params p{};
    for (int i = 0; i < 31; ++i) p.in[i] = (const float*)d_in[i];
    p.out = (float*)d_out; p.ws = (unsigned char*)d_ws;
    void* args[] = {&p};
    hipError_t e = hipLaunchCooperativeKernel((const void*)fwd_megakernel, dim3(grid_blocks), dim3(512), args, LDS_BYTES, stream);
    if (e != hipSuccess) fprintf(stderr, "kernel_launch: cooperative launch failed: %s (grid %d)\n", hipGetErrorString(e), grid_blocks);
}
```

```cpp
#include <hip/hip_runtime.h>
#include <hip/hip_bf16.h>
#include <hip/hip_cooperative_groups.h>
#include <cstdio>
#include <cstdint>
namespace cg = cooperative_groups;
__device__ __forceinline__ int tidx() { int t = threadIdx.x; asm volatile("" : "+v"(t)); return t; }

namespace pg8 {
#define PG8_LAS __attribute__((address_space(3)))
typedef unsigned short bf16_t;
typedef short bf16x8 __attribute__((ext_vector_type(8)));
typedef float f32x4 __attribute__((ext_vector_type(4)));
typedef unsigned u32x4 __attribute__((ext_vector_type(4)));
constexpr int BM = 256, BK = 64, HALF = 128, HTB = HALF * BK * 2  , STAGE_BYTES = 8 * HTB, NXCD = 8, WGM = 8;

__host__ __device__ __forceinline__ int lds_byte(int r, int c) { const int st = (r >> 4) * 2 + (c >> 5), rr = r & 15, cc = c & 31, ob = rr * 64 + cc * 2; return st * 1024 + (ob ^ (((ob >> 9) & 1) << 5)); }
__host__ __device__ __forceinline__ void stage_rc(int b, int& R, int& C) { const int st = b / 1024, sb = b % 1024, swz = sb ^ (((sb >> 9) & 1) << 5); R = (st >> 1) * 16 + swz / 64; C = (st & 1) * 32 + (swz % 64) / 2; }
__host__ __device__ __forceinline__ int perm32(int rho) { const int n = rho >> 4, i = rho & 15; return 8 * (i >> 2) + 4 * n + (i & 3); }

struct Unit { int pm, pn, kt0, nkt, split; };
struct Gemm { const bf16_t* A; const bf16_t* Bt; int M, N, K; };

struct StaticOrder {
    int nM, nN, nwg, G, c;
    __host__ __device__ void init(int M, int N, int G_, int c_) { nM = M / BM; nN = N / BM; nwg = nM * nN; G = G_; c = c_; }
    __host__ __device__ bool next(int i, Unit& u) const {
        const long L = (long)i * G + c; if (L >= nwg) return false;
        int wgid = (int)L; { const int q = nwg / NXCD, r = nwg % NXCD, xcd = wgid % NXCD, off = wgid / NXCD; wgid = (xcd < r ? xcd * (q + 1) : r * (q + 1) + (xcd - r) * q) + off; }
        const int nig = WGM * nN, gid = wgid / nig, fm = gid * WGM, gsz = (nM - fm) < WGM ? (nM - fm) : WGM;
        u.pm = fm + ((wgid % nig) % gsz); u.pn = (wgid % nig) / gsz; u.kt0 = 0; u.nkt = 0; u.split = -1; return true;
    }
    __device__ __forceinline__ void a_ready(const Unit&) const {}
    __device__ __forceinline__ void done(const Unit&) const {}
};

__device__ __forceinline__ unsigned cvt_pk_bf16(float lo, float hi) { unsigned r; asm volatile("v_cvt_pk_bf16_f32 %0, %1, %2" : "=v"(r) : "v"(lo), "v"(hi)); return r; }

struct SplitOrder {
    int G, c, nt;
    __host__ __device__ void init(int K, int G_, int c_) { nt = K / BK; G = G_; c = c_; }
    __host__ __device__ bool next(int i, Unit& u) const {
        const int L = i * G + c; if (L >= 512 + 256) return false;
        int tile;
        if (L < 512) { tile = (L % NXCD) * 64 + L / NXCD; u.kt0 = 0; u.nkt = 0; u.split = -1; }
        else { const int r = L - 512, s = r & 3; tile = 512 + (r >> 2);
            const int q = (nt / 4) & ~1, rp = (nt - 4 * q) / 2;
            u.split = s; u.nkt = q + (s < rp ? 2 : 0); u.kt0 = s * q + 2 * (s < rp ? s : rp); }
        const int gid = tile >> 5, w = tile & 31;
        u.pm = gid * 8 + (w & 7); u.pn = w >> 3; return true;
    }
    __device__ __forceinline__ void a_ready(const Unit&) const {}
    __device__ __forceinline__ void done(const Unit&) const {}
};
typedef unsigned u32x2 __attribute__((ext_vector_type(2)));
struct EpiBf16 {
    static constexpr bool PERM = true, AFTER_DRAIN = false;
    bf16_t* O; int ldc; const float* bias;
    __device__ __forceinline__ void operator()(const f32x4 (&acc)[2][2][4][2], const Unit& u, int wr, int wc, int fr, int fq) const {
        const int row0 = u.pm * BM + wr * 64 + fr; const int col0 = u.pn * BM + wc * 32 + 8 * fq;
        f32x4 bv[2][2];
#pragma unroll
        for (int bj = 0; bj < 2; ++bj)
#pragma unroll
            for (int n = 0; n < 2; ++n) bv[bj][n] = *(const f32x4*)(bias + col0 + bj * HALF + 4 * n);
#pragma unroll
        for (int ai = 0; ai < 2; ++ai)
#pragma unroll
            for (int m = 0; m < 4; ++m) { bf16_t* rowp = O + (size_t)(row0 + ai * HALF + m * 16) * ldc + col0;
#pragma unroll
                for (int bj = 0; bj < 2; ++bj) { const f32x4 v0 = acc[ai][bj][m][0] + bv[bj][0], v1 = acc[ai][bj][m][1] + bv[bj][1];
                    u32x4 w; w.x = cvt_pk_bf16(v0[0], v0[1]); w.y = cvt_pk_bf16(v0[2], v0[3]); w.z = cvt_pk_bf16(v1[0], v1[1]); w.w = cvt_pk_bf16(v1[2], v1[3]);
                    *(u32x4*)(rowp + bj * HALF) = w; } }
    }
};
__device__ __forceinline__ float silu_f(float x) { return x * __builtin_amdgcn_rcpf(1.0f + __builtin_amdgcn_exp2f(-1.4426950408889634f * x)); }
struct EpiSwiglu {
    static constexpr bool PERM = true, AFTER_DRAIN = false;
    bf16_t* O;
    __device__ __forceinline__ void operator()(const f32x4 (&acc)[2][2][4][2], const Unit& u, int wr, int wc, int fr, int fq) const {
        const int row0 = u.pm * BM + wr * 64 + fr; const int col0 = u.pn * HALF + wc * 32 + 8 * fq;
#pragma unroll
        for (int ai = 0; ai < 2; ++ai)
#pragma unroll
            for (int m = 0; m < 4; ++m) { bf16_t* rowp = O + (size_t)(row0 + ai * HALF + m * 16) * 2816 + col0;
                const f32x4 g0 = acc[ai][0][m][0], g1 = acc[ai][0][m][1], u0 = acc[ai][1][m][0], u1 = acc[ai][1][m][1];
                float r[8];
#pragma unroll
                for (int i = 0; i < 4; ++i) { r[i] = silu_f(g0[i]) * u0[i]; r[4 + i] = silu_f(g1[i]) * u1[i]; }
                u32x4 w; w.x = cvt_pk_bf16(r[0], r[1]); w.y = cvt_pk_bf16(r[2], r[3]); w.z = cvt_pk_bf16(r[4], r[5]); w.w = cvt_pk_bf16(r[6], r[7]);
                *(u32x4*)rowp = w; }
    }
};
struct EpiRes {
    static constexpr bool PERM = true, AFTER_DRAIN = false;
    bf16_t* X16; const float* xs_ctx; const float* xs_smp; const float* gate; const float* bias; int first;
    __device__ __forceinline__ void operator()(const f32x4 (&acc)[2][2][4][2], const Unit& u, int wr, int wc, int fr, int fq) const {
        const int g = u.pm >> 4; const float* gp = gate + (size_t)g * 6144;
        const int col0 = u.pn * BM + wc * 32 + 8 * fq;
#pragma unroll
        for (int bj = 0; bj < 2; ++bj) {
            const int co = col0 + bj * HALF;
            const f32x4 gv0 = *(const f32x4*)(gp + co), gv1 = *(const f32x4*)(gp + co + 4);
            const f32x4 bv0 = bias ? *(const f32x4*)(bias + co) : (f32x4){0.f, 0.f, 0.f, 0.f}, bv1 = bias ? *(const f32x4*)(bias + co + 4) : (f32x4){0.f, 0.f, 0.f, 0.f};
#pragma unroll
            for (int ai = 0; ai < 2; ++ai)
#pragma unroll
                for (int m = 0; m < 4; ++m) { const int row = u.pm * BM + ai * HALF + wr * 64 + m * 16 + fr;
                    bf16_t* xo = X16 + (size_t)row * 1024 + co;
                    f32x4 o0, o1;
                    if (first) { const float* xs = (g == 0 ? xs_ctx + (size_t)row * 1024 : xs_smp + (size_t)(row - 4096) * 1024) + co; o0 = __builtin_nontemporal_load((const f32x4*)xs); o1 = __builtin_nontemporal_load((const f32x4*)(xs + 4)); }
                    else { const u32x4 w = __builtin_nontemporal_load((const u32x4*)xo); o0 = (f32x4){__builtin_bit_cast(float, w.x << 16), __builtin_bit_cast(float, w.x & 0xffff0000u), __builtin_bit_cast(float, w.y << 16), __builtin_bit_cast(float, w.y & 0xffff0000u)};
                        o1 = (f32x4){__builtin_bit_cast(float, w.z << 16), __builtin_bit_cast(float, w.z & 0xffff0000u), __builtin_bit_cast(float, w.w << 16), __builtin_bit_cast(float, w.w & 0xffff0000u)}; }
                    const f32x4 n0 = o0 + gv0 * (acc[ai][bj][m][0] + bv0), n1 = o1 + gv1 * (acc[ai][bj][m][1] + bv1);
                    u32x4 wn; wn.x = cvt_pk_bf16(n0[0], n0[1]); wn.y = cvt_pk_bf16(n0[2], n0[3]); wn.z = cvt_pk_bf16(n1[0], n1[1]); wn.w = cvt_pk_bf16(n1[2], n1[3]);
                    *(u32x4*)xo = wn; }
        }
    }
};
constexpr float QSCALE = 0.125f * 1.4426950408889634f;
struct EpiQKV {
    static constexpr bool PERM = false, AFTER_DRAIN = false;
    unsigned char* qbase; float* ck; const float* rcos; const float* rsin;
    __device__ __forceinline__ void operator()(const f32x4 (&acc)[2][2][4][2], const Unit& u, int wr, int wc, int fr, int fq) const {
        const int part = u.pn >> 2, colt = (u.pn & 3) * BM, g = u.pm >> 4;
        const int col0 = colt + wc * 32 + 4 * fq;
        const bool rope = (g > 0) && (part < 2);
        const int axis = wc & 1;
        bf16_t* const dstb = (bf16_t*)(qbase + (size_t)part * (72u << 20) + (size_t)(part >> 1) * (8u << 20));
        float* const cdst = ck + (size_t)(part >> 1) * ((size_t)16 * 2 * 256 * 1024);
#pragma unroll
        for (int ai = 0; ai < 2; ++ai)
#pragma unroll
            for (int m = 0; m < 4; ++m) {
                const int row = u.pm * BM + ai * HALF + wr * 64 + m * 16 + fr;
                const int t = row & 4095;
                f32x4 c4 = (f32x4){1.f, 1.f, 1.f, 1.f}, s4 = (f32x4){0.f, 0.f, 0.f, 0.f};
                if (rope) { const int posi = axis ? (t & 63) : (t >> 6); c4 = *(const f32x4*)(rcos + posi * 16 + 4 * fq); s4 = *(const f32x4*)(rsin + posi * 16 + 4 * fq); }
                size_t drow = (size_t)row;
                if (part != 0 && g > 0) drow = (size_t)(4096 + (g - 1) * 4608 + 512 + t);
                bf16_t* base = dstb + drow * 1024 + col0;
#pragma unroll
                for (int bj = 0; bj < 2; ++bj) {
                    const f32x4 v0 = acc[ai][bj][m][0], v1 = acc[ai][bj][m][1];
                    const bool odd = fq & 1; const int cofs = bj * HALF + (odd ? 12 : 0);
                    if (g == 0 && part != 0) { float* o = cdst + (size_t)(row >> 8) * (2 * 256 * 1024) + (size_t)(row & 255) * 1024 + col0 + cofs;
                        const f32x4 snd = odd ? v0 : v1; f32x4 rcv; rcv[0] = __shfl_xor(snd[0], 16); rcv[1] = __shfl_xor(snd[1], 16); rcv[2] = __shfl_xor(snd[2], 16); rcv[3] = __shfl_xor(snd[3], 16);
                        __builtin_nontemporal_store(odd ? rcv : v0, (f32x4*)o); __builtin_nontemporal_store(odd ? v1 : rcv, (f32x4*)(o + 4)); }
                    f32x4 o0 = v0 * c4 - v1 * s4, o1 = v1 * c4 + v0 * s4;
                    if (part == 0) { o0 = o0 * QSCALE; o1 = o1 * QSCALE; }
                    u32x2 w0, w1; w0.x = cvt_pk_bf16(o0[0], o0[1]); w0.y = cvt_pk_bf16(o0[2], o0[3]); w1.x = cvt_pk_bf16(o1[0], o1[1]); w1.y = cvt_pk_bf16(o1[2], o1[3]);
                    const u32x2 snd = odd ? w0 : w1; u32x2 rcv; rcv.x = __shfl_xor(snd.x, 16); rcv.y = __shfl_xor(snd.y, 16);
                    u32x4 wo; if (odd) { wo.x = rcv.x; wo.y = rcv.y; wo.z = w1.x; wo.w = w1.y; } else { wo.x = w0.x; wo.y = w0.y; wo.z = rcv.x; wo.w = rcv.y; }
                    *(u32x4*)(base + cofs) = wo; }
            }
    }
};

template <class Epi, class Sched, bool ALIGN_EPI = false, bool SP2 = false>
__device__ __forceinline__ void gemm_phase(PG8_LAS unsigned char* lds, const Gemm g, const Sched& S, const Epi& E) {
    const int tid = tidx(), wid = __builtin_amdgcn_readfirstlane(tid >> 6), lane = tid & 63, wr = wid >> 2, wc = wid & 3, fr = lane & 15, fq = lane >> 4;
    const int K = g.K, nt = K / BK;
    unsigned voffA[2], voffB[2];
#pragma unroll
    for (int i = 0; i < 2; ++i) { int R, C; stage_rc(tid * 16 + i * 8192, R, C); const int Rb = Epi::PERM ? ((R & ~31) + perm32(R & 31)) : R;
        voffA[i] = (unsigned)(R * K + C) * 2u; voffB[i] = (unsigned)(Rb * K + C) * 2u; }
    const size_t kstep = (size_t)(BK * 2);
    const size_t hstep = (size_t)HALF * K * 2;
    const size_t tstep = 2 * hstep;
    const unsigned ldsw = (unsigned)wid * 1024u;
    const int aoff = lds_byte(wr * 64 + fr, fq * 8), boff = lds_byte(wc * 32 + fr, fq * 8);
#define PG8_SA(b, h) (((b) * 2 + (h)) * HTB)
#define PG8_SB(b, h) ((4 + (b) * 2 + (h)) * HTB)
#define PG8_STAGE(bufoff, gbase, voff) do { _Pragma("unroll") for (int _i = 0; _i < 2; ++_i) \
        __builtin_amdgcn_global_load_lds((const unsigned*)((const char*)(gbase) + (voff)[_i]), (PG8_LAS unsigned*)(lds + (bufoff) + ldsw + _i * 8192), 16, 0, 0); } while (0)
#define PG8_LDA(dst, b, h) do { _Pragma("unroll") for (int m = 0; m < 4; ++m) _Pragma("unroll") for (int k = 0; k < 2; ++k) dst[m][k] = *(const PG8_LAS bf16x8*)(lds + PG8_SA(b, h) + aoff + m * 2048 + k * 1024); } while (0)
#define PG8_LDB(dst, b, h) do { _Pragma("unroll") for (int n = 0; n < 2; ++n) _Pragma("unroll") for (int k = 0; k < 2; ++k) dst[n][k] = *(const PG8_LAS bf16x8*)(lds + PG8_SB(b, h) + boff + n * 2048 + k * 1024); } while (0)
#define PG8_MMA(ai, bj, At, Bt) do { __builtin_amdgcn_s_setprio(1); _Pragma("unroll") for (int m = 0; m < 4; ++m) _Pragma("unroll") for (int n = 0; n < 2; ++n) _Pragma("unroll") for (int k = 0; k < 2; ++k) \
        acc[ai][bj][m][n] = __builtin_amdgcn_mfma_f32_16x16x32_bf16(Bt[n][k], At[m][k], acc[ai][bj][m][n], 0, 0, 0); __builtin_amdgcn_s_setprio(0); } while (0)
#define PG8_WAIT_V(n) asm volatile("s_waitcnt vmcnt(" #n ")" ::: "memory")
#define PG8_WAIT_L(n) asm volatile("s_waitcnt lgkmcnt(" #n ")" ::: "memory")
#define PG8_BAR __builtin_amdgcn_s_barrier()
#define PG8_SCHED __builtin_amdgcn_sched_barrier(0)
    Unit cur, nxt; int ui = 0;
    if (!S.next(0, cur)) return;
    f32x4 acc[2][2][4][2];
#pragma unroll
    for (int a = 0; a < 2; ++a)
#pragma unroll
        for (int b = 0; b < 2; ++b)
#pragma unroll
            for (int m = 0; m < 4; ++m)
#pragma unroll
                for (int n = 0; n < 2; ++n) acc[a][b][m][n] = (f32x4){0.f, 0.f, 0.f, 0.f};
    bf16x8 At[4][2], B0[2][2], B1[2][2];
    const char* cA = (const char*)g.A + (size_t)cur.pm * tstep + (size_t)cur.kt0 * kstep; const char* cB = (const char*)g.Bt + (size_t)cur.pn * tstep + (size_t)cur.kt0 * kstep;
    S.a_ready(cur);
    if constexpr (SP2) {
        PG8_STAGE(PG8_SB(0, 0), cB, voffB); PG8_STAGE(PG8_SB(0, 1), cB + hstep, voffB); PG8_STAGE(PG8_SA(0, 0), cA, voffA); PG8_STAGE(PG8_SA(0, 1), cA + hstep, voffA);
        if (wr == 1) PG8_BAR;
        PG8_WAIT_V(2); PG8_BAR;
        PG8_STAGE(PG8_SB(1, 0), cB + kstep, voffB); PG8_STAGE(PG8_SA(1, 0), cA + kstep, voffA); PG8_STAGE(PG8_SB(1, 1), cB + hstep + kstep, voffB);
        PG8_WAIT_V(6); PG8_BAR;
    } else {
        PG8_STAGE(PG8_SB(0, 0), cB, voffB); PG8_STAGE(PG8_SA(0, 0), cA, voffA); PG8_STAGE(PG8_SB(0, 1), cB + hstep, voffB); PG8_STAGE(PG8_SA(0, 1), cA + hstep, voffA);
        if (wr == 1) PG8_BAR;
        PG8_WAIT_V(4); PG8_BAR;
        PG8_STAGE(PG8_SB(1, 0), cB + kstep, voffB); PG8_STAGE(PG8_SA(1, 0), cA + kstep, voffA); PG8_STAGE(PG8_SB(1, 1), cB + hstep + kstep, voffB);
        PG8_WAIT_V(6); PG8_BAR;
    }
    for (;;) {
        const bool has_next = S.next(ui + 1, nxt);
        const char* nA = has_next ? (const char*)g.A + (size_t)nxt.pm * tstep + (size_t)nxt.kt0 * kstep : cA; const char* nB = has_next ? (const char*)g.Bt + (size_t)nxt.pn * tstep + (size_t)nxt.kt0 * kstep : cB;
        const int unt = cur.nkt ? cur.nkt : nt;
        for (int t = 0; t < unt; t += 2) {
            const bool last = (t == unt - 2);
            const char* a1 = cA + (size_t)(t + 1) * kstep;
            const char* a2 = last ? nA : cA + (size_t)(t + 2) * kstep; const char* b2 = last ? nB : cB + (size_t)(t + 2) * kstep;
            const char* a3 = a2 + kstep; const char* b3 = b2 + kstep;
            if (last && has_next) S.a_ready(nxt);
            if constexpr (SP2) {
            PG8_LDB(B0, 0, 0); PG8_LDB(B1, 0, 1); PG8_SCHED; PG8_LDA(At, 0, 0); PG8_STAGE(PG8_SA(1, 1), a1 + hstep, voffA);
            PG8_WAIT_V(8); PG8_WAIT_L(0); PG8_BAR; PG8_MMA(0, 0, At, B0); PG8_MMA(0, 1, At, B1); PG8_BAR; PG8_SCHED;
            PG8_LDA(At, 0, 1); PG8_STAGE(PG8_SB(0, 0), b2, voffB); PG8_STAGE(PG8_SB(0, 1), b2 + hstep, voffB); PG8_STAGE(PG8_SA(0, 0), a2, voffA);
            PG8_WAIT_V(8); PG8_WAIT_L(0); PG8_BAR; PG8_MMA(1, 0, At, B0); PG8_MMA(1, 1, At, B1); PG8_BAR; PG8_SCHED;
            PG8_LDB(B0, 1, 0); PG8_LDB(B1, 1, 1); PG8_SCHED; PG8_LDA(At, 1, 0); PG8_STAGE(PG8_SA(0, 1), a2 + hstep, voffA);
            PG8_WAIT_V(8); PG8_WAIT_L(0); PG8_BAR; PG8_MMA(0, 0, At, B0); PG8_MMA(0, 1, At, B1); PG8_BAR; PG8_SCHED;
            PG8_LDA(At, 1, 1); PG8_STAGE(PG8_SB(1, 0), b3, voffB); PG8_STAGE(PG8_SB(1, 1), b3 + hstep, voffB); PG8_STAGE(PG8_SA(1, 0), a3, voffA);
            PG8_WAIT_V(8); PG8_WAIT_L(0); PG8_BAR; PG8_MMA(1, 0, At, B0); PG8_MMA(1, 1, At, B1); PG8_BAR; PG8_SCHED;
            } else {
            PG8_LDB(B0, 0, 0); PG8_SCHED; PG8_LDA(At, 0, 0); PG8_STAGE(PG8_SA(1, 1), a1 + hstep, voffA);
            PG8_WAIT_L(8); PG8_BAR; PG8_WAIT_L(0); PG8_MMA(0, 0, At, B0); PG8_BAR; PG8_SCHED;
            PG8_LDB(B1, 0, 1); PG8_STAGE(PG8_SB(0, 0), b2, voffB);
            PG8_BAR; PG8_WAIT_L(0); PG8_MMA(0, 1, At, B1); PG8_BAR;
            PG8_LDA(At, 0, 1); PG8_STAGE(PG8_SA(0, 0), a2, voffA);
            PG8_BAR; PG8_WAIT_L(0); PG8_MMA(1, 0, At, B0); PG8_BAR; PG8_SCHED;
            PG8_STAGE(PG8_SB(0, 1), b2 + hstep, voffB);
            PG8_WAIT_V(6); PG8_BAR; PG8_MMA(1, 1, At, B1); PG8_BAR;
            PG8_LDB(B0, 1, 0); PG8_SCHED; PG8_LDA(At, 1, 0); PG8_STAGE(PG8_SA(0, 1), a2 + hstep, voffA);
            PG8_WAIT_L(8); PG8_BAR; PG8_WAIT_L(0); PG8_MMA(0, 0, At, B0); PG8_BAR; PG8_SCHED;
            PG8_LDB(B1, 1, 1); PG8_STAGE(PG8_SB(1, 0), b3, voffB);
            PG8_BAR; PG8_WAIT_L(0); PG8_MMA(0, 1, At, B1); PG8_BAR;
            PG8_LDA(At, 1, 1); PG8_STAGE(PG8_SA(1, 0), a3, voffA);
            PG8_BAR; PG8_WAIT_L(0); PG8_MMA(1, 0, At, B0); PG8_BAR; PG8_SCHED;
            PG8_STAGE(PG8_SB(1, 1), b3 + hstep, voffB);
            PG8_WAIT_V(6); PG8_BAR; PG8_MMA(1, 1, At, B1); PG8_BAR;
            }
        }
        if constexpr (ALIGN_EPI) { if (wr == 0) PG8_BAR; }
        if constexpr (!Epi::AFTER_DRAIN) { E(acc, cur, wr, wc, fr, fq); S.done(cur); }
        if (!has_next) break;
#pragma unroll
        for (int a = 0; a < 2; ++a)
#pragma unroll
            for (int b = 0; b < 2; ++b)
#pragma unroll
                for (int m = 0; m < 4; ++m)
#pragma unroll
                    for (int n = 0; n < 2; ++n) acc[a][b][m][n] = (f32x4){0.f, 0.f, 0.f, 0.f};
        cur = nxt; cA = nA; cB = nB; ++ui;
        if constexpr (ALIGN_EPI) { if (wr == 1) PG8_BAR; }
    }
    PG8_WAIT_V(0);
    if constexpr (!ALIGN_EPI) { if (wr == 0) PG8_BAR; }
    PG8_BAR;
    if constexpr (Epi::AFTER_DRAIN) { E.fused(acc, cur, wr, wc, fr, fq, lds, wid, lane); S.done(cur); }
#undef PG8_SA
#undef PG8_SB
#undef PG8_STAGE
#undef PG8_LDA
#undef PG8_LDB
#undef PG8_MMA
#undef PG8_WAIT_V
#undef PG8_WAIT_L
#undef PG8_BAR
#undef PG8_SCHED
}
}
namespace attn {
using bf16 = __hip_bfloat16;
constexpr int NW = 8, QBLK = 32, KVBLK = 64, LD = 1024;
constexpr float SCALE = 0.125f;
constexpr float THR = 8.f;
constexpr size_t SHM_V = KVBLK * 128 * 2, SHM_K = KVBLK * 128 * 2, SHM_ATTN = 2 * SHM_V + 2 * SHM_K + NW * 64 * 4;
using bf16x8 = __attribute__((ext_vector_type(8))) short;
using s16x4  = __attribute__((ext_vector_type(4))) short;
using f32x16 = __attribute__((ext_vector_type(16))) float;
using u32x4  = __attribute__((ext_vector_type(4))) unsigned;
#define KSWZ(row, colB) ((row) * 256 + ((colB) ^ (((row) & 7) << 4)))
#define SBAR() __builtin_amdgcn_sched_barrier(0)
__device__ __forceinline__ int crow(int r, int hi) { return (r & 3) + 8 * (r >> 2) + 4 * hi; }
__device__ __forceinline__ unsigned cvtpk(float lo, float hi) { unsigned r; asm volatile("v_cvt_pk_bf16_f32 %0, %1, %2" : "=v"(r) : "v"(lo), "v"(hi)); return r; }
__device__ __forceinline__ bf16x8 ld8(const bf16* p) { return *reinterpret_cast<const bf16x8*>(p); }

constexpr float THRL = THR * 1.4426950408889634f;
template <bool FIRST> __device__ __forceinline__ void partialSM(f32x16& p0, f32x16& p1, float& m_reg, float& alpha) {
  float pmax = fmaxf(fmaxf(p0[0], p0[1]), p1[0]);
#pragma unroll
  for (int r = 2; r < 16; r += 2) pmax = fmaxf(fmaxf(pmax, p0[r]), p0[r + 1]);
#pragma unroll
  for (int r = 1; r < 15; r += 2) pmax = fmaxf(fmaxf(pmax, p1[r]), p1[r + 1]);
  pmax = fmaxf(pmax, p1[15]);
  { auto rr = __builtin_amdgcn_permlane32_swap(__float_as_uint(pmax), __float_as_uint(pmax), false, false);
    pmax = fmaxf(__uint_as_float(rr[0]), __uint_as_float(rr[1])); }
  alpha = 1.f;
  if (FIRST || !__builtin_expect(__all(pmax <= THRL), 1)) {
    const float dl = FIRST ? pmax : fmaxf(pmax, 0.f);
    m_reg += dl; if (!FIRST) alpha = __builtin_amdgcn_exp2f(-dl);
#pragma unroll
    for (int r = 0; r < 16; ++r) { p0[r] -= dl; p1[r] -= dl; }
  }
#pragma unroll
  for (int r = 0; r < 16; ++r) p0[r] = __builtin_amdgcn_exp2f(p0[r]);
}
__device__ __forceinline__ void finishSM(f32x16& p0, f32x16& p1, float alpha, float& l_reg, bf16x8& pa0, bf16x8& pa1, bf16x8& pa2, bf16x8& pa3) {
#pragma unroll
  for (int r = 0; r < 16; ++r) p1[r] = __builtin_amdgcn_exp2f(p1[r]);
  float ps;
  { const f32x16 t = p0 + p1; typedef float f32x8v __attribute__((ext_vector_type(8))); typedef float f32x4v __attribute__((ext_vector_type(4))); typedef float f32x2v __attribute__((ext_vector_type(2)));
    const f32x8v t8 = __builtin_shufflevector(t, t, 0, 1, 2, 3, 4, 5, 6, 7) + __builtin_shufflevector(t, t, 8, 9, 10, 11, 12, 13, 14, 15);
    const f32x4v t4 = __builtin_shufflevector(t8, t8, 0, 1, 2, 3) + __builtin_shufflevector(t8, t8, 4, 5, 6, 7);
    const f32x2v t2 = __builtin_shufflevector(t4, t4, 0, 1) + __builtin_shufflevector(t4, t4, 2, 3); ps = t2.x + t2.y; }
  { auto rr = __builtin_amdgcn_permlane32_swap(__float_as_uint(ps), __float_as_uint(ps), false, false);
    ps = __uint_as_float(rr[0]) + __uint_as_float(rr[1]); }
  l_reg = l_reg * alpha + ps;
#define PK4(P, BASE, OUT) do { unsigned a0 = cvtpk(P[BASE + 0], P[BASE + 1]), a1 = cvtpk(P[BASE + 2], P[BASE + 3]);   \
    unsigned b0 = cvtpk(P[BASE + 4], P[BASE + 5]), b1 = cvtpk(P[BASE + 6], P[BASE + 7]);                              \
    auto r0 = __builtin_amdgcn_permlane32_swap(a0, b0, false, false); auto r1 = __builtin_amdgcn_permlane32_swap(a1, b1, false, false); \
    u32x4 w = {r0[0], r1[0], r0[1], r1[1]}; OUT = *reinterpret_cast<bf16x8*>(&w); } while (0)
  PK4(p0, 0, pa0); PK4(p0, 8, pa1); PK4(p1, 0, pa2); PK4(p1, 8, pa3);
#undef PK4
}
__device__ __forceinline__ void qkt(f32x16& p0, f32x16& p1, const bf16* Ks, const bf16x8* qr, int r32, int hi, float m_ref) {
  { const float nm = -m_ref;
#pragma unroll
    for (int r = 0; r < 16; ++r) { p0[r] = nm; p1[r] = nm; } }
#pragma unroll
  for (int d0 = 0; d0 < 4; ++d0) { int cb = (d0 * 16 + hi * 8) * 2;
    bf16x8 b0 = *reinterpret_cast<const bf16x8*>((const char*)Ks + KSWZ(r32, cb));
    bf16x8 b1 = *reinterpret_cast<const bf16x8*>((const char*)Ks + KSWZ(32 + r32, cb));
    p0 = __builtin_amdgcn_mfma_f32_32x32x16_bf16(b0, qr[d0], p0, 0, 0, 0);
    p1 = __builtin_amdgcn_mfma_f32_32x32x16_bf16(b1, qr[d0], p1, 0, 0, 0); }
}
__device__ __forceinline__ int v_st(int k, int c) { const int kk = (k & ~0xC) | ((k & 4) << 1) | ((k & 8) >> 1); return ((kk >> 3) * 4 + (c >> 5)) * 512 + ((kk & 7) * 32 + (c & 31)) * 2; }
__device__ __forceinline__ int v_rd_base(int lane) { return ((lane & 3) << 3) | (((lane >> 2) & 3) << 6) | (((lane >> 4) & 1) << 5) | (((lane >> 5) & 1) << 8); }
constexpr int v_rd_off(int d0, int ks, int half) { return d0 * 512 + ks * 4096 + half * 2048; }
template <int OFF> __device__ __forceinline__ s16x4 tr_read(int vb) {
  s16x4 r; asm volatile("ds_read_b64_tr_b16 %0, %1 offset:%2" : "=&v"(r) : "v"(vb), "i"(OFF) : "memory"); return r;
}
template <int D0> __device__ __forceinline__ void pv_one(f32x16& od, int vb, bf16x8 pa0, bf16x8 pa1, bf16x8 pa2, bf16x8 pa3) {
  const s16x4 l0 = tr_read<v_rd_off(D0, 0, 0)>(vb), h0 = tr_read<v_rd_off(D0, 0, 1)>(vb), l1 = tr_read<v_rd_off(D0, 1, 0)>(vb), h1 = tr_read<v_rd_off(D0, 1, 1)>(vb);
  const s16x4 l2 = tr_read<v_rd_off(D0, 2, 0)>(vb), h2 = tr_read<v_rd_off(D0, 2, 1)>(vb), l3 = tr_read<v_rd_off(D0, 3, 0)>(vb), h3 = tr_read<v_rd_off(D0, 3, 1)>(vb);
  asm volatile("s_waitcnt lgkmcnt(0)" ::: "memory"); SBAR();
#define PK(L, H) (bf16x8){L[0], L[1], L[2], L[3], H[0], H[1], H[2], H[3]}
  od = __builtin_amdgcn_mfma_f32_32x32x16_bf16(pa0, PK(l0, h0), od, 0, 0, 0);
  od = __builtin_amdgcn_mfma_f32_32x32x16_bf16(pa1, PK(l1, h1), od, 0, 0, 0);
  od = __builtin_amdgcn_mfma_f32_32x32x16_bf16(pa2, PK(l2, h2), od, 0, 0, 0);
  od = __builtin_amdgcn_mfma_f32_32x32x16_bf16(pa3, PK(l3, h3), od, 0, 0, 0);
#undef PK
}
__device__ __forceinline__ void pv_d0(f32x16* o, int vb, bf16x8 pa0, bf16x8 pa1, bf16x8 pa2, bf16x8 pa3) {
  pv_one<0>(o[0], vb, pa0, pa1, pa2, pa3); pv_one<1>(o[1], vb, pa0, pa1, pa2, pa3); pv_one<2>(o[2], vb, pa0, pa1, pa2, pa3); pv_one<3>(o[3], vb, pa0, pa1, pa2, pa3);
}
struct AUnit { const bf16* Q; const bf16* K; const bf16* V; bf16* O; int seq; };
template <class Units> __device__ __forceinline__ void attn_run(const Units& U, char* lds) {
  const int tid = tidx(), wid = tid >> 6, lane = tid & 63, r32 = lane & 31, hi = lane >> 5;
  bf16* V_lds = (bf16*)lds; bf16* K_lds = (bf16*)(lds + 2 * SHM_V);
  float* ws = (float*)(lds + 2 * SHM_V + 2 * SHM_K) + wid * 64; float* li_l = ws; float* al_l = ws + 32;
  const int sr = tid >> 4, sc = (tid & 15) * 8, vst0 = v_st(sr, sc), vst1 = v_st(32 + sr, sc);
  const int kr = tid >> 3, kc = (tid & 7) * 8, kst = KSWZ(kr, kc * 2);
  const int vb0 = (int)(uintptr_t)V_lds + v_rd_base(lane);
  struct { bf16x8 vs0, vs1, ks0; } sr_[2];
  bf16x8 qr[4];
  constexpr int SE = 0, SO = 1;
  const unsigned voff0 = (unsigned)(sr * LD + sc), voff1 = (unsigned)((32 + sr) * LD + sc), koff = (unsigned)(kr * LD + kc);
#define SLOADU(i, UN, k0) do { const bf16* vt_ = (UN).V + (size_t)(k0) * LD; const bf16* kt_ = (UN).K + (size_t)(k0) * LD; \
    sr_[i].vs0 = ld8(vt_ + voff0); sr_[i].vs1 = ld8(vt_ + voff1); sr_[i].ks0 = ld8(kt_ + koff); } while (0)
#define QLOADU(UN) do { const bf16* Qw_ = (UN).Q + (long)(wid * QBLK + r32) * LD + hi * 8; \
    _Pragma("unroll") for (int d0 = 0; d0 < 4; ++d0) qr[d0] = __builtin_nontemporal_load(reinterpret_cast<const bf16x8*>(Qw_ + d0 * 16)); } while (0)
#define SLOAD(i, k0) SLOADU(i, cur, k0)
#define SWRITE(b, i) do { *(bf16x8*)((char*)V_lds + (b) * SHM_V + vst0) = sr_[i].vs0;          \
    *(bf16x8*)((char*)V_lds + (b) * SHM_V + vst1) = sr_[i].vs1;               \
    *(bf16x8*)((char*)K_lds + (b) * SHM_K + kst) = sr_[i].ks0; } while (0)
#define SWAIT() asm volatile("s_waitcnt vmcnt(3)" ::: "memory")
#define RESC(a) do { if (__any((a) < 1.f)) { if (hi == 0) al_l[r32] = (a); asm volatile("s_waitcnt lgkmcnt(0)" ::: "memory"); \
    _Pragma("unroll") for (int d = 0; d < 4; ++d) _Pragma("unroll") for (int r = 0; r < 16; ++r) o[d][r] *= al_l[crow(r, hi)]; } } while (0)
  { AUnit f; if (U.get(0, f)) { SLOADU(SE, f, 0); } }
#pragma unroll 1
  for (int ui = 0; ; ++ui) {
    AUnit cur; if (!U.get(ui, cur)) break;
    QLOADU(cur);
    float m_reg = 0.f, l_reg = 0; f32x16 o[4] = {};
    f32x16 pA0, pA1, pB0, pB1; float alA, alB; bf16x8 pa0, pa1, pa2, pa3; const int NT = cur.seq / KVBLK;
    SWRITE(0, SE); __syncthreads();
    qkt(pA0, pA1, K_lds, qr, r32, hi, 0.f); partialSM<true>(pA0, pA1, m_reg, alA);
    SLOAD(SO, KVBLK); if (2 < NT) SLOAD(SE, 2 * KVBLK);
    SWAIT(); SWRITE(1, SO); __syncthreads();
    for (int j = 1; j + 1 < NT; j += 2) {
      SBAR(); qkt(pB0, pB1, (bf16*)((char*)K_lds + SHM_K), qr, r32, hi, m_reg);
      finishSM(pA0, pA1, alA, l_reg, pa0, pa1, pa2, pa3); SBAR();
      SLOAD(SO, (j + 2) * KVBLK); SBAR();
      pv_d0(o, vb0, pa0, pa1, pa2, pa3); partialSM<false>(pB0, pB1, m_reg, alB);
      __syncthreads(); SWAIT(); SWRITE(0, SE);
      RESC(alB); __syncthreads();
      SBAR(); qkt(pA0, pA1, K_lds, qr, r32, hi, m_reg);
      finishSM(pB0, pB1, alB, l_reg, pa0, pa1, pa2, pa3); SBAR();
      if (j + 3 < NT) SLOAD(SE, (j + 3) * KVBLK); SBAR();
      pv_d0(o, vb0 + (int)SHM_V, pa0, pa1, pa2, pa3); partialSM<false>(pA0, pA1, m_reg, alA);
      __syncthreads(); SWAIT(); SWRITE(1, SO);
      RESC(alA); __syncthreads();
    }
    SBAR(); qkt(pB0, pB1, (bf16*)((char*)K_lds + SHM_K), qr, r32, hi, m_reg);
    finishSM(pA0, pA1, alA, l_reg, pa0, pa1, pa2, pa3); SBAR();
    { AUnit nxt; if (U.get(ui + 1, nxt)) { SLOADU(SE, nxt, 0); } } SBAR();
    pv_d0(o, vb0, pa0, pa1, pa2, pa3); partialSM<false>(pB0, pB1, m_reg, alB);
    __syncthreads(); RESC(alB);
    finishSM(pB0, pB1, alB, l_reg, pa0, pa1, pa2, pa3); SBAR();
    pv_d0(o, vb0 + (int)SHM_V, pa0, pa1, pa2, pa3);
    if (hi == 0) li_l[r32] = l_reg; asm volatile("s_waitcnt lgkmcnt(0)" ::: "memory");
    float rli[16];
#pragma unroll
    for (int r = 0; r < 16; ++r) rli[r] = __builtin_amdgcn_rcpf(li_l[crow(r, hi)]);
    bf16* Ow = cur.O + (long)(wid * QBLK) * LD;
#pragma unroll
    for (int r = 0; r < 16; ++r) { int orow = crow(r, hi);
#pragma unroll
      for (int d0 = 0; d0 < 4; ++d0) Ow[(long)orow * LD + d0 * 32 + r32] = __float2bfloat16(o[d0][r] * rli[r]); }
    __syncthreads();
  }
#undef SLOADU
#undef QLOADU
#undef SLOAD
#undef SWRITE
#undef SWAIT
#undef RESC
}
#undef KSWZ
#undef SBAR
}

#define FFT_HD __device__ __forceinline__
#ifndef FFT_HD
#define FFT_HD __host__ __device__ __forceinline__
#endif
typedef float cf __attribute__((ext_vector_type(2)));
FFT_HD cf cmul(cf a, cf b) { const cf t = {-a.y, a.x}; return a * b.x + t * b.y; }
FFT_HD cf cmulc(cf a, cf b) { const cf t = {a.y, -a.x}; return a * b.x + t * b.y; }
FFT_HD int fpad(int i) { return i + (i >> 4); }
FFT_HD cf twid(float rev) {
#if defined(__HIP_DEVICE_COMPILE__)
  return cf{__builtin_amdgcn_cosf(rev), -__builtin_amdgcn_sinf(rev)};
#else
  return cf{cosf(6.283185307179586f * rev), -sinf(6.283185307179586f * rev)};
#endif
}
FFT_HD cf rot16(cf d, int k) {
  const float s = 0.70710678119f, c1 = 0.92387953251f, s1 = 0.38268343236f;
  switch (k & 15) {
    case 0: return d;
    case 4: return cf{d.y, -d.x};
    case 8: return cf{-d.x, -d.y};
    case 12: return cf{-d.y, d.x};
    case 2: return cf{(d.x + d.y) * s, (d.y - d.x) * s};
    case 6: return cf{(d.y - d.x) * s, -(d.x + d.y) * s};
    case 10: return cf{-(d.x + d.y) * s, (d.x - d.y) * s};
    case 14: return cf{(d.x - d.y) * s, (d.x + d.y) * s};
    case 1: return cmul(d, cf{c1, -s1});
    case 3: return cmul(d, cf{s1, -c1});
    case 5: return cmul(d, cf{-s1, -c1});
    case 7: return cmul(d, cf{-c1, -s1});
    case 9: return cmul(d, cf{-c1, s1});
    case 11: return cmul(d, cf{-s1, c1});
    case 13: return cmul(d, cf{s1, c1});
    default: return cmul(d, cf{c1, s1});
  }
}
template <int LOG_R, bool UNIT, bool ZHALF> FFT_HD void dif_group(cf (&v)[1 << LOG_R], cf w0) {
  constexpr int R = 1 << LOG_R;
  cf wk = w0;
#pragma unroll
  for (int k = 0; k < LOG_R; ++k) {
    const int half = R >> (k + 1);
#pragma unroll
    for (int m = 0; m < R; ++m) {
      if ((m & half) == 0) {
        const int mm = m & (half - 1);
        cf d;
        if (ZHALF && k == 0) { d = v[m]; }
        else { const cf a = v[m], b = v[m + half]; d = a - b; v[m] = a + b; }
        if (!UNIT) d = cmul(d, wk);
        v[m + half] = rot16(d, (mm << k) * (16 / R));
      }
    }
    if (!UNIT) wk = cmul(wk, wk);
  }
}
template <int LOG_R, bool UNIT, bool LOWONLY> FFT_HD void dit_group(cf (&v)[1 << LOG_R], cf w0) {
  constexpr int R = 1 << LOG_R;
  cf wp[LOG_R];
  wp[0] = w0;
#pragma unroll
  for (int k = 1; k < LOG_R; ++k) wp[k] = cmul(wp[k - 1], wp[k - 1]);
#pragma unroll
  for (int k = LOG_R - 1; k >= 0; --k) {
    const int half = R >> (k + 1);
#pragma unroll
    for (int m = 0; m < R; ++m) {
      if ((m & half) == 0) {
        const int mm = m & (half - 1);
        cf B = rot16(v[m + half], 16 - (mm << k) * (16 / R));
        if (!UNIT) B = cmulc(B, wp[k]);
        const cf A = v[m];
        v[m] = A + B;
        if (!(LOWONLY && k == 0)) v[m + half] = A - B;
      }
    }
  }
}
template <int S> FFT_HD constexpr int goff(int m) { return S >= 16 ? m * S + m * (S / 16) : m * S + ((m * S) >> 4); }
template <bool INV, int LC, class P> FFT_HD void fft_pass8(P a, int NTOT, int tid, int nthr) {
  constexpr int S = LC >> 3;
  static_assert(S >= 8, "fft_pass8: S >= 8");
  for (int g = tid; g < (NTOT >> 3); g += nthr) {
    const int blk = g / S, j = g - blk * S, pb = fpad(blk * LC + j);
    cf v[8];
#pragma unroll
    for (int m = 0; m < 8; ++m) v[m] = a[pb + goff<S>(m)];
    const cf w0 = twid((float)j * (1.0f / (float)LC));
    if (INV) dit_group<3, false, false>(v, w0); else dif_group<3, false, false>(v, w0);
#pragma unroll
    for (int m = 0; m < 8; ++m) a[pb + goff<S>(m)] = v[m];
  }
}
constexpr int DM = 1024, T_ALL = 36864, NGRP = 9, DFF = 2816;
constexpr size_t MiB = 1u << 20;
constexpr size_t WS_MODS = 64 * 1024;
constexpr size_t WS_ROPE = 1008 * 1024;
constexpr size_t WS_HDN2 = 1 * MiB;
constexpr size_t WS_W1 = 4 * MiB, WS_W2 = 10 * MiB, WS_WGU = 12 * MiB, WS_WDN = 23 * MiB;
constexpr size_t WS_H = 29 * MiB;
constexpr size_t WS_BIG = 101 * MiB;
constexpr size_t WS_Q = WS_BIG, WS_K = WS_BIG + 72 * MiB, WS_V = WS_K + 80 * MiB, WS_O1 = WS_V + 80 * MiB;
constexpr size_t WS_U = WS_BIG, WS_VXT = WS_BIG + 216 * MiB;
constexpr size_t WS_ACT = WS_BIG;
constexpr size_t WS_X16 = WS_BIG + 304 * MiB;
constexpr size_t WS_FILT = WS_X16 + 72 * MiB;
constexpr size_t WS_END = WS_FILT + 34 * MiB;
static_assert(WS_END <= 512 * MiB && WS_O1 + 72 * MiB <= WS_X16 && WS_VXT + 72 * MiB <= WS_X16, "ws map");
constexpr int LDS_BYTES = 147456;

typedef unsigned short bf16_t;
typedef float f32x4 __attribute__((ext_vector_type(4)));
typedef unsigned u32x4 __attribute__((ext_vector_type(4)));
typedef unsigned u32x2 __attribute__((ext_vector_type(2)));

struct Params { const float* in[31]; float* out; unsigned char* ws; };
typedef const __attribute__((address_space(4))) unsigned char* kargp_t;
__device__ __forceinline__ unsigned long long karg_u64(int i) {
    const volatile __attribute__((address_space(4))) unsigned* k = (const volatile __attribute__((address_space(4))) unsigned*)__builtin_amdgcn_kernarg_segment_ptr();
    const unsigned lo = __builtin_amdgcn_readfirstlane(k[2 * i]), hi = __builtin_amdgcn_readfirstlane(k[2 * i + 1]);
    return ((unsigned long long)hi << 32) | lo; }
#define GAS1 __attribute__((address_space(1)))
__device__ __forceinline__ const float* INP(int i) { return (const float*)(const GAS1 float*)karg_u64(i); }
__device__ __forceinline__ float* OUTP() { return (float*)(GAS1 float*)karg_u64(31); }
__device__ __forceinline__ unsigned char* WSP() { return (unsigned char*)(GAS1 unsigned char*)karg_u64(32); }
enum { I_XP = 0, I_XS, I_CK, I_CV, I_C, I_CCTX, I_ADAW, I_ADAB, I_N1G, I_N2G, I_WQKV, I_LAM, I_SUBG, I_WO, I_HWIN, I_HBIN, I_HCW, I_HCB,
       I_FW1, I_FB1, I_FW2, I_FB2, I_FW3, I_FB3, I_FFREQ, I_SKIP, I_HWOUT, I_HBOUT, I_WGU, I_WDN, I_FING };

__device__ __forceinline__ unsigned f2bf(float f) { unsigned u = __builtin_bit_cast(unsigned, f); return (u + 0x7fffu + ((u >> 16) & 1u)) >> 16; }
__device__ __forceinline__ unsigned pk2(float lo, float hi) { return f2bf(lo) | (f2bf(hi) << 16); }
__device__ __forceinline__ float bf2f(unsigned short b) { return __builtin_bit_cast(float, (unsigned)b << 16); }
__device__ __forceinline__ float bflo(unsigned w) { return __builtin_bit_cast(float, w << 16); }
__device__ __forceinline__ float bfhi(unsigned w) { return __builtin_bit_cast(float, w & 0xffff0000u); }
template <class T> __device__ __forceinline__ T ldnt(const T* p) { return __builtin_nontemporal_load(p); }
__device__ __forceinline__ float wave_sum(float v) {
#pragma unroll
    for (int o = 1; o < 64; o <<= 1) v += __shfl_xor(v, o);
    return v;
}

__device__ __forceinline__ void transpose_item(const float* W, int K, int N, bf16_t* WT, float* scr, int item, int lane, int mode) {
    const int nblk = N / 32, kb = item / nblk, nb = item % nblk, k0 = 64 * kb, n0 = 32 * nb;
    int n0p = n0;
    if (mode == 1) { const int part = n0 >= DFF ? 1 : 0, jj = n0 - part * DFF; n0p = 256 * (jj >> 7) + 128 * part + (jj & 127); }
#pragma unroll 8
    for (int i = 0; i < 32; ++i) { const int kk = 2 * i + (lane >> 5); scr[kk * 33 + (lane & 31)] = ldnt(W + (size_t)(k0 + kk) * N + n0 + (lane & 31)); }
    __builtin_amdgcn_s_waitcnt(0); asm volatile("" ::: "memory");
    const int c = lane & 7;
#pragma unroll
    for (int j = 0; j < 4; ++j) { const int n = (lane >> 3) + 8 * j; const float* s = scr + (8 * c) * 33 + n;
        u32x4 o; o.x = pk2(s[0 * 33], s[1 * 33]); o.y = pk2(s[2 * 33], s[3 * 33]); o.z = pk2(s[4 * 33], s[5 * 33]); o.w = pk2(s[6 * 33], s[7 * 33]);
        *(u32x4*)(WT + (size_t)(n0p + n) * K + k0 + 8 * c) = o; }
    __builtin_amdgcn_s_waitcnt(0); asm volatile("" ::: "memory");
}
__device__ __forceinline__ void phase_convert_weights(int layer, unsigned char* lds, int which, int bidx, int nblk) {
    const int wid = tidx() >> 6, lane = tidx() & 63;
    float* scr = (float*)(lds + wid * 16384);
    const int gw = bidx * 8 + wid, NGW = nblk * 8;
    const int j = layer >> 1; const bool hy = layer & 1;
    const float* w1 = hy ? INP(I_HWIN) + (size_t)j * 1024 * 3072 : INP(I_WQKV) + (size_t)j * 1024 * 3072;
    const float* w2 = hy ? INP(I_HWOUT) + (size_t)j * 1024 * 1024 : INP(I_WO) + (size_t)j * 1024 * 1024;
    const float* wgu = INP(I_WGU) + (size_t)layer * 1024 * 5632;
    const float* wdn = INP(I_WDN) + (size_t)layer * 2816 * 1024;
    constexpr int I1 = 16 * 96, I2 = 16 * 32, I3 = 16 * 176, I4 = 44 * 32;
    const int lo = which == 2 ? I1 + I2 + I3 : 0, hi = which == 1 ? I1 + I2 + I3 : I1 + I2 + I3 + I4;
    for (int it = lo + gw; it < hi; it += NGW) {
        int r = it;
        if (r < I1) { transpose_item(w1, 1024, 3072, (bf16_t*)(WSP() + WS_W1), scr, r, lane, 0); continue; } r -= I1;
        if (r < I2) { transpose_item(w2, 1024, 1024, (bf16_t*)(WSP() + WS_W2), scr, r, lane, 0); continue; } r -= I2;
        if (r < I3) { transpose_item(wgu, 1024, 5632, (bf16_t*)(WSP() + WS_WGU), scr, r, lane, 1); continue; } r -= I3;
        transpose_item(wdn, 2816, 1024, (bf16_t*)(WSP() + WS_WDN), scr, r, lane, 0);
    }
}

__device__ __forceinline__ void phase0(unsigned char* lds) {
    const int tid = tidx(), wid = tid >> 6, lane = tid & 63;
    {
        float* sc = (float*)lds;
        float* red = (float*)(lds + 9 * 1024 * 4);
        if ((int)blockIdx.x < 192) {
            for (int e = tid; e < 9 * 1024; e += 512) { const int g = e >> 10, k = e & 1023; const float x = g == 0 ? INP(I_CCTX)[k] : INP(I_C)[(g - 1) * 1024 + k];
                sc[e] = x / (1.0f + expf(-x)); }
            __syncthreads();
            for (int it = blockIdx.x; it < 192; it += gridDim.x) {
                const int i = it / 48, chunk = it % 48, cg4 = tid & 31, kl = tid >> 5;
                f32x4 acc[9];
#pragma unroll
                for (int g = 0; g < 9; ++g) acc[g] = (f32x4){0.f, 0.f, 0.f, 0.f};
                const float* wp = INP(I_ADAW) + (size_t)i * 1024 * 6144 + chunk * 128 + cg4 * 4;
                for (int k = kl; k < 1024; k += 16) { const f32x4 w = ldnt((const f32x4*)(wp + (size_t)k * 6144));
#pragma unroll
                    for (int g = 0; g < 9; ++g) acc[g] += w * sc[g * 1024 + k]; }
#pragma unroll
                for (int g = 0; g < 9; ++g) *(f32x4*)(red + (kl * 9 + g) * 128 + cg4 * 4) = acc[g];
                __syncthreads();
                for (int e = tid; e < 9 * 128; e += 512) { const int g = e >> 7, col = e & 127; float s = INP(I_ADAB)[i * 6144 + chunk * 128 + col];
#pragma unroll
                    for (int q = 0; q < 16; ++q) s += red[(q * 9 + g) * 128 + col];
                    ((float*)(WSP() + WS_MODS))[((size_t)i * 9 + g) * 6144 + chunk * 128 + col] = s; }
                __syncthreads();
            }
        }
    }
    {
        const int gw = blockIdx.x * 8 + wid, NGW = gridDim.x * 8;
        for (int idx = gw; idx < 2 * 4352; idx += NGW) {
            const int jh = idx / 4352, r = idx % 4352; const int L = r < 4096 ? 4096 : 256, pos = r < 4096 ? r : r - 4096;
            const float fpos = (float)pos;
            const float tt = fpos / (float)(L - 1);
            const float w = 6.283185307179586f * fpos / (float)L;
            float z;
            { const int bi = lane == 0 ? 0 : ((lane - 1) & 15); const float band = 1e-4f + (float)bi * ((15.0f - 1e-4f) / 15.0f); const float a = w * band;
              z = lane == 0 ? tt : (lane <= 16 ? cosf(a) : -sinf(a)); }
            const float* w1 = INP(I_FW1) + (size_t)jh * 33 * 64; const float* w2 = INP(I_FW2) + (size_t)jh * 64 * 64;
            const float fr = INP(I_FFREQ)[jh * 64 + lane];
            float a1 = INP(I_FB1)[jh * 64 + lane];
            for (int f = 0; f < 33; ++f) a1 += __shfl(z, f) * w1[f * 64 + lane];
            const float h1 = sinf(fr * a1);
            float a2 = INP(I_FB2)[jh * 64 + lane];
            for (int k = 0; k < 64; ++k) a2 += __shfl(h1, k) * w2[k * 64 + lane];
            ((float*)(WSP() + WS_HDN2))[(size_t)idx * 64 + lane] = sinf(fr * a2);
        }
    }
    if (blockIdx.x == gridDim.x - 1) {
        for (int e = tid; e < 1024; e += 512) { const int posi = e >> 4, f = e & 15; const float inv = powf(10000.0f, -(float)f / 16.0f); const float ang = (float)posi * inv;
            ((float*)(WSP() + WS_ROPE))[e] = cosf(ang); ((float*)(WSP() + WS_ROPE))[1024 + e] = sinf(ang); }
    }
}

__device__ __forceinline__ void phase_norm(const float* gamma, const float* mods_l, int shift_idx, bool first) {
    const int wid = tidx() >> 6, lane = tidx() & 63;
    const int gw = blockIdx.x * 8 + wid, NGW = gridDim.x * 8;
    bf16_t* H = (bf16_t*)(WSP() + WS_H);
    const float* xc = INP(I_XP); const float* xm = INP(I_XS); const bf16_t* X16 = (const bf16_t*)(WSP() + WS_X16);
    f32x4 gm[4];
#pragma unroll
    for (int j = 0; j < 4; ++j) gm[j] = *(const f32x4*)(gamma + 4 * lane + 256 * j);
    for (int row0 = gw; row0 < T_ALL; row0 += 2 * NGW) {
        f32x4 v[2][4]; float s[2];
#pragma unroll
        for (int q = 0; q < 2; ++q) { const int row = row0 + q * NGW; s[q] = 0.f;
            if (row < T_ALL) {
                if (first) { const f32x4* xr = (const f32x4*)(row < 4096 ? xc + (size_t)row * 1024 : xm + (size_t)(row - 4096) * 1024) + lane;
#pragma unroll
                    for (int j = 0; j < 4; ++j) v[q][j] = ldnt(xr + 64 * j); }
                else { const u32x2* xr = (const u32x2*)(X16 + (size_t)row * 1024) + lane;
#pragma unroll
                    for (int j = 0; j < 4; ++j) { const u32x2 w = ldnt(xr + 64 * j); v[q][j] = (f32x4){bflo(w.x), bfhi(w.x), bflo(w.y), bfhi(w.y)}; } }
#pragma unroll
                for (int j = 0; j < 4; ++j) s[q] += (v[q][j].x * v[q][j].x + v[q][j].y * v[q][j].y) + (v[q][j].z * v[q][j].z + v[q][j].w * v[q][j].w); } }
#pragma unroll
        for (int q = 0; q < 2; ++q) { const int row = row0 + q * NGW;
            if (row < T_ALL) {
                const float* mp = mods_l + (size_t)(row >> 12) * 6144;
                const float rstd = 1.0f / sqrtf(wave_sum(s[q]) * (1.0f / 1024.0f) + 1e-6f);
                u32x2* o = (u32x2*)(H + (size_t)row * 1024) + lane;
#pragma unroll
                for (int j = 0; j < 4; ++j) { const f32x4 sh = *(const f32x4*)(mp + shift_idx * 1024 + 4 * lane + 256 * j), scl = *(const f32x4*)(mp + (shift_idx + 1) * 1024 + 4 * lane + 256 * j);
                    const f32x4 y = v[q][j] * rstd * gm[j] * (scl + 1.0f) + sh;
                    u32x2 w; w.x = pk2(y.x, y.y); w.y = pk2(y.z, y.w); o[64 * j] = w; } } }
    }
}
__device__ __forceinline__ void phase_final_norm() {
    const int wid = tidx() >> 6, lane = tidx() & 63;
    const int gw = blockIdx.x * 8 + wid, NGW = gridDim.x * 8;
    const float* gamma = INP(I_FING); const bf16_t* X16 = (const bf16_t*)(WSP() + WS_X16);
    f32x4 gm[4];
#pragma unroll
    for (int j = 0; j < 4; ++j) gm[j] = *(const f32x4*)(gamma + 4 * lane + 256 * j);
    for (int row = gw; row < T_ALL; row += NGW) {
        const u32x2* xr = (const u32x2*)(X16 + (size_t)row * 1024) + lane;
        f32x4 v[4]; float s = 0.f;
#pragma unroll
        for (int j = 0; j < 4; ++j) { const u32x2 w = xr[64 * j]; v[j] = (f32x4){bflo(w.x), bfhi(w.x), bflo(w.y), bfhi(w.y)}; s += (v[j].x * v[j].x + v[j].y * v[j].y) + (v[j].z * v[j].z + v[j].w * v[j].w); }
        const float rstd = 1.0f / sqrtf(wave_sum(s) * (1.0f / 1024.0f) + 1e-6f);
        f32x4* o = (f32x4*)(OUTP() + (size_t)row * 1024) + lane;
#pragma unroll
        for (int j = 0; j < 4; ++j) __builtin_nontemporal_store(v[j] * rstd * gm[j], o + 64 * j);
    }
}
__device__ __forceinline__ void phase_cache_convert(int j) {
    bf16_t* Kb = (bf16_t*)(WSP() + WS_K); bf16_t* Vb = (bf16_t*)(WSP() + WS_V);
    const size_t n8 = (size_t)8 * 512 * 1024 / 8;
    for (size_t i = (size_t)blockIdx.x * 512 + tidx(); i < 2 * n8; i += (size_t)gridDim.x * 512) {
        const bool isv = i >= n8; const size_t e = (isv ? i - n8 : i) * 8; const int b = (int)(e / (512 * 1024)); const size_t rem = e % (512 * 1024);
        const float* src = (isv ? INP(I_CV) : INP(I_CK)) + ((size_t)(b * 2 + j) * 512 * 1024) + rem;
        const f32x4 a = ldnt((const f32x4*)src), c = ldnt((const f32x4*)(src + 4));
        u32x4 w; w.x = pk2(a.x, a.y); w.y = pk2(a.z, a.w); w.z = pk2(c.x, c.y); w.w = pk2(c.z, c.w);
        *(u32x4*)((isv ? Vb : Kb) + (size_t)(4096 + b * 4608) * 1024 + rem) = w;
    }
}
struct AttnUnits {
    int vcu, G;
    __device__ __forceinline__ bool get(int i, attn::AUnit& u) const {
        const int id = vcu + i * G; if (id >= 2048 + 256) return false;
        int b, h, mp; size_t qrow, krow;
        if (id < 2048) { const int bh = id >> 5, r = id & 31; b = bh >> 3; h = bh & 7; mp = r >> 4; const int qb = r & 15; u.seq = 4608;
            qrow = (size_t)4096 + (size_t)b * 4096 + qb * 256; krow = (size_t)4096 + (size_t)b * 4608; }
        else { const int r = id - 2048; b = r >> 4; h = (r >> 1) & 7; mp = r & 1; u.seq = 256; qrow = (size_t)b * 256; krow = qrow; }
        unsigned char* ws = WSP();
        u.Q = (const attn::bf16*)(ws + WS_Q) + qrow * 1024 + h * 128 + mp * 64; u.K = (const attn::bf16*)(ws + WS_K) + krow * 1024 + h * 128 + mp * 64; u.V = (const attn::bf16*)(ws + WS_V) + krow * 1024 + h * 128;
        u.O = (attn::bf16*)(ws + (mp ? WS_O1 : WS_H)) + qrow * 1024 + h * 128; return true;
    }
};
__device__ __forceinline__ void phase_attention(unsigned char* lds) {
    const int G = gridDim.x, bx = blockIdx.x; const int vcu = (G % 8 == 0) ? (bx % 8) * (G / 8) + bx / 8 : bx;
    AttnUnits U{vcu, G};
    attn::attn_run(U, (char*)lds);
}
__device__ __forceinline__ void phase_combine(int layer) {
    const int wid = tidx() >> 6, lane = tidx() & 63;
    const int gw = blockIdx.x * 8 + wid, NGW = gridDim.x * 8;
    const int j = layer >> 1;
    const float* lp = INP(I_LAM) + (size_t)j * 4 * 64;
    const float s1 = wave_sum(lp[lane] * lp[64 + lane]), s2 = wave_sum(lp[128 + lane] * lp[192 + lane]);
    const float lam_init = 0.8f - 0.6f * expf(-0.3f * (float)layer);
    const float lam = expf(s1) - expf(s2) + lam_init;
    const float osc = 1.0f - lam_init;
    bf16_t* O0 = (bf16_t*)(WSP() + WS_H); const bf16_t* O1 = (const bf16_t*)(WSP() + WS_O1);
    float gsub[16];
#pragma unroll
    for (int e = 0; e < 16; ++e) gsub[e] = INP(I_SUBG)[j * 128 + (lane & 7) * 16 + e] * osc;
    for (int row = gw; row < T_ALL; row += NGW) {
        u32x4* a = (u32x4*)(O0 + (size_t)row * 1024) + lane * 2; const u32x4* c = (const u32x4*)(O1 + (size_t)row * 1024) + lane * 2;
        const u32x4 a0 = ldnt((const u32x4*)a), a1 = ldnt((const u32x4*)a + 1), c0 = ldnt(c), c1 = ldnt(c + 1);
        float v[16];
#pragma unroll
        for (int q = 0; q < 4; ++q) { v[2 * q] = bflo(a0[q]) - lam * bflo(c0[q]); v[2 * q + 1] = bfhi(a0[q]) - lam * bfhi(c0[q]);
            v[8 + 2 * q] = bflo(a1[q]) - lam * bflo(c1[q]); v[8 + 2 * q + 1] = bfhi(a1[q]) - lam * bfhi(c1[q]); }
        float s = 0.f;
#pragma unroll
        for (int e = 0; e < 16; ++e) s += v[e] * v[e];
        s += __shfl_xor(s, 1); s += __shfl_xor(s, 2); s += __shfl_xor(s, 4);
        const float rstd = 1.0f / sqrtf(s * (1.0f / 128.0f) + 1e-5f);
        u32x4 w0, w1;
#pragma unroll
        for (int q = 0; q < 4; ++q) { w0[q] = pk2(v[2 * q] * rstd * gsub[2 * q], v[2 * q + 1] * rstd * gsub[2 * q + 1]);
            w1[q] = pk2(v[8 + 2 * q] * rstd * gsub[8 + 2 * q], v[8 + 2 * q + 1] * rstd * gsub[8 + 2 * q + 1]); }
        a[0] = w0; a[1] = w1;
    }
}
__device__ __forceinline__ size_t vxt_index(int row, int c) {
    return row < 4096 ? ((size_t)((row >> 8) * 1024 + c) * 256 + (row & 255)) : ((size_t)4096 * 1024 + ((size_t)(((row - 4096) >> 12) * 1024 + c) * 4096) + (row & 4095));
}
__device__ __forceinline__ void unpack8(const u32x4 w, float* f) {
#pragma unroll
    for (int q = 0; q < 4; ++q) { f[2 * q] = bflo(w[q]); f[2 * q + 1] = bfhi(w[q]); }
}
__device__ __forceinline__ void phase_conv3(int jh, unsigned char* lds) {
    const int tid = tidx();
    const bf16_t* U = (const bf16_t*)(WSP() + WS_U); bf16_t* X0 = (bf16_t*)(WSP() + WS_H); bf16_t* VXT = (bf16_t*)(WSP() + WS_VXT);
    float* tile = (float*)lds;
    const float* cw = INP(I_HCW) + (size_t)jh * 3 * 3072; const float* cb = INP(I_HCB) + (size_t)jh * 3072;
    const int tl = tid >> 3, c8 = (tid & 7) * 8;
    for (int it = blockIdx.x; it < 576 * 8; it += gridDim.x) {
        const int tt = it >> 3, ct = it & 7; const int row = tt * 64 + tl;
        const int L = row < 4096 ? 256 : 4096; const int ts = row & (L - 1);
        const bool hasp = ts > 0, hasn = ts < L - 1;
        u32x4 uc[2][3], um[2][3], un[2][3];
#pragma unroll
        for (int hf = 0; hf < 2; ++hf)
#pragma unroll
            for (int part = 1; part < 3; ++part) {
                const bf16_t* up = U + (size_t)row * 3072 + part * 1024 + ct * 128 + hf * 64 + c8;
                uc[hf][part] = ldnt((const u32x4*)up);
                um[hf][part] = hasp ? ldnt((const u32x4*)(up - 3072)) : (u32x4){0u, 0u, 0u, 0u};
                un[hf][part] = hasn ? ldnt((const u32x4*)(up + 3072)) : (u32x4){0u, 0u, 0u, 0u};
            }
#pragma unroll
        for (int hf = 0; hf < 2; ++hf) {
            const int c0 = ct * 128 + hf * 64 + c8;
            float res[3][8];
#pragma unroll
            for (int part = 1; part < 3; ++part) {
                const int col = part * 1024 + c0;
                float fm[8], fc[8], fn[8]; unpack8(um[hf][part], fm); unpack8(uc[hf][part], fc); unpack8(un[hf][part], fn);
#pragma unroll
                for (int e = 0; e < 8; ++e) res[part][e] = fm[e] * cw[col + e] + fc[e] * cw[3072 + col + e] + fn[e] * cw[6144 + col + e] + cb[col + e];
            }
#pragma unroll
            for (int e = 0; e < 8; ++e) tile[(hf * 64 + c8 + e) * 65 + tl] = res[2][e] * res[1][e];
        }
        __syncthreads();
#pragma unroll
        for (int hf = 0; hf < 2; ++hf) { const int cl = hf * 64 + (tid >> 3), t8 = (tid & 7) * 8; const int r0 = tt * 64 + t8, c = ct * 128 + cl;
          f32x4 a, b; a.x = tile[cl * 65 + t8]; a.y = tile[cl * 65 + t8 + 1]; a.z = tile[cl * 65 + t8 + 2]; a.w = tile[cl * 65 + t8 + 3];
          b.x = tile[cl * 65 + t8 + 4]; b.y = tile[cl * 65 + t8 + 5]; b.z = tile[cl * 65 + t8 + 6]; b.w = tile[cl * 65 + t8 + 7];
          u32x4 w; w.x = pk2(a.x, a.y); w.y = pk2(a.z, a.w); w.z = pk2(b.x, b.y); w.w = pk2(b.z, b.w); *(u32x4*)(VXT + vxt_index(r0, c)) = w; }
        __syncthreads();
    }
}
__device__ __forceinline__ void phase_gate(int jh, unsigned char* lds) {
    const int tid = tidx();
    bf16_t* Z = (bf16_t*)(WSP() + WS_H); const bf16_t* VXT = (const bf16_t*)(WSP() + WS_VXT); const bf16_t* U = (const bf16_t*)(WSP() + WS_U);
    const float* cw = INP(I_HCW) + (size_t)jh * 3 * 3072; const float* cb = INP(I_HCB) + (size_t)jh * 3072;
    float* tile = (float*)lds;
    for (int it = blockIdx.x; it < 576 * 8; it += gridDim.x) {
        const int tt = it >> 3, ct = it & 7;
        const int tl = tid >> 3, c8 = (tid & 7) * 8; const int row = tt * 64 + tl;
        const int L = row < 4096 ? 256 : 4096; const int ts = row & (L - 1);
        const bool hasp = ts > 0, hasn = ts < L - 1;
        f32x4 ya[2], yb[2]; u32x4 uc[2], um[2], un[2];
#pragma unroll
        for (int hf = 0; hf < 2; ++hf) { const int cl = hf * 64 + (tid >> 3), t8 = (tid & 7) * 8; const int r0 = tt * 64 + t8, c = ct * 128 + cl;
          const u32x4 w = ldnt((const u32x4*)(VXT + vxt_index(r0, c))); ya[hf] = (f32x4){bflo(w.x), bfhi(w.x), bflo(w.y), bfhi(w.y)}; yb[hf] = (f32x4){bflo(w.z), bfhi(w.z), bflo(w.w), bfhi(w.w)}; }
#pragma unroll
        for (int hf = 0; hf < 2; ++hf) { const bf16_t* up = U + (size_t)row * 3072 + ct * 128 + hf * 64 + c8;
          uc[hf] = ldnt((const u32x4*)up); um[hf] = hasp ? ldnt((const u32x4*)(up - 3072)) : (u32x4){0u, 0u, 0u, 0u}; un[hf] = hasn ? ldnt((const u32x4*)(up + 3072)) : (u32x4){0u, 0u, 0u, 0u}; }
#pragma unroll
        for (int hf = 0; hf < 2; ++hf) { const int cl = hf * 64 + (tid >> 3), t8 = (tid & 7) * 8;
          tile[(t8 + 0) * 129 + cl] = ya[hf].x; tile[(t8 + 1) * 129 + cl] = ya[hf].y; tile[(t8 + 2) * 129 + cl] = ya[hf].z; tile[(t8 + 3) * 129 + cl] = ya[hf].w;
          tile[(t8 + 4) * 129 + cl] = yb[hf].x; tile[(t8 + 5) * 129 + cl] = yb[hf].y; tile[(t8 + 6) * 129 + cl] = yb[hf].z; tile[(t8 + 7) * 129 + cl] = yb[hf].w; }
        __syncthreads();
#pragma unroll
        for (int hf = 0; hf < 2; ++hf) { const int cc = hf * 64 + c8, col = ct * 128 + cc;
          float fm[8], fc[8], fn[8]; unpack8(um[hf], fm); unpack8(uc[hf], fc); unpack8(un[hf], fn);
          float r[8];
#pragma unroll
          for (int e = 0; e < 8; ++e) { const float x0 = fm[e] * cw[col + e] + fc[e] * cw[3072 + col + e] + fn[e] * cw[6144 + col + e] + cb[col + e]; r[e] = x0 * tile[tl * 129 + cc + e]; }
          u32x4 w; w.x = pk2(r[0], r[1]); w.y = pk2(r[2], r[3]); w.z = pk2(r[4], r[5]); w.w = pk2(r[6], r[7]); *(u32x4*)(Z + (size_t)row * 1024 + col) = w; }
        __syncthreads();
    }
}
__device__ __forceinline__ void phase_filter(int jh, unsigned char* lds, int bidx, int nblk) {
    const int tid = tidx(), lx = tid & 63, cgp = tid >> 6;
    float* hs = (float*)lds;
    float* w3s = (float*)(lds + 64 * 65 * 4);
    const float* tab = (const float*)(WSP() + WS_HDN2) + (size_t)jh * 4352 * 64;
    const float* w3 = INP(I_FW3) + (size_t)jh * 64 * 2048; const float* b3 = INP(I_FB3) + jh * 2048;
    float* hT = (float*)(WSP() + WS_FILT);
    __syncthreads();
    for (int it = bidx; it < 68 * 8; it += nblk) {
        const int lt = it >> 3, ctile = it & 7; const int l0 = lt * 64, col0 = ctile * 256;
        for (int e = tid; e < 64 * 64; e += 512) hs[(e >> 6) * 65 + (e & 63)] = tab[(size_t)l0 * 64 + e];
        for (int e = tid; e < 64 * 256; e += 512) w3s[e] = w3[(size_t)(e >> 8) * 2048 + col0 + (e & 255)];
        __syncthreads();
        float acc[32];
#pragma unroll
        for (int q = 0; q < 32; ++q) acc[q] = 0.f;
#pragma unroll 4
        for (int k = 0; k < 64; ++k) { const float hv = hs[lx * 65 + k]; const f32x4* wr = (const f32x4*)(w3s + k * 256 + cgp * 32);
#pragma unroll
            for (int q = 0; q < 8; ++q) { const f32x4 w = wr[q]; acc[4 * q] += hv * w.x; acc[4 * q + 1] += hv * w.y; acc[4 * q + 2] += hv * w.z; acc[4 * q + 3] += hv * w.w; } }
        const int r = l0 + lx; const int L = r < 4096 ? 4096 : 256, pos = r < 4096 ? r : r - 4096;
        const float tl = (float)pos / (float)(L - 1);
        float* ob = r < 4096 ? hT : hT + (size_t)1024 * 2 * 4096;
#pragma unroll
        for (int q = 0; q < 32; ++q) { const int col = col0 + cgp * 32 + q, dir = col >> 10, c = col & 1023;
            const float delta = fabsf(-3.0701134573253945f + (-15.350567286626973f + 3.0701134573253945f) * ((float)c / 1023.0f));
            ob[(size_t)(c * 2 + dir) * L + pos] = (acc[q] + b3[col]) * expf(-tl * delta); }
        __syncthreads();
    }
}
template <bool INV, int LOG_N> __device__ __forceinline__ void fft_mid(cf* a, int NTOT, int tid) {
    if constexpr (LOG_N == 13) {
        if (!INV) { fft_pass8<false, 1024>(a, NTOT, tid, 512); __syncthreads(); fft_pass8<false, 128>(a, NTOT, tid, 512); __syncthreads(); }
        else { fft_pass8<true, 128>(a, NTOT, tid, 512); __syncthreads(); fft_pass8<true, 1024>(a, NTOT, tid, 512); __syncthreads(); }
    } else { fft_pass8<INV, 64>(a, NTOT, tid, 512); __syncthreads(); }
}
template <int LOG_N>
__device__ __forceinline__ void hyena_fft_unit(int jh, int c, unsigned char* lds, bool dry) {
    constexpr int N = 1 << LOG_N, L = N / 2, LOG_L = LOG_N - 1, LOG_LAST = (LOG_N % 3 == 1) ? 4 : 3, RL = 1 << LOG_LAST, S0 = N / 8;
    constexpr int NAR = (LOG_N == 13) ? 2 : 8, NRND = (LOG_N == 13) ? 2 : 1, NTOT = NAR * N;
    const int tid = tidx();
    cf* a = (cf*)lds;
    float* wl = (float*)(lds + 139264);
    bf16_t* vbase = (bf16_t*)(WSP() + WS_VXT) + (LOG_N == 13 ? (size_t)4096 * 1024 : 0);
    const float* hT = (const float*)(WSP() + WS_FILT) + (LOG_N == 13 ? (size_t)0 : (size_t)1024 * 2 * 4096) + (size_t)c * 2 * L;
    float asum = 0.f;
#pragma unroll 4
    for (int i = tid; i < N; i += 512) {
        const float hv = i < L ? hT[i] : hT[L + (i == L ? 0 : N - i)];
        asum += fabsf(hv);
        a[fpad(i)] = cf{i == L ? 0.f : hv, 0.f};
    }
    asum = wave_sum(asum);
    if ((tid & 63) == 0) wl[136 + (tid >> 6)] = asum;
    __syncthreads();
    float tot = 0.f;
#pragma unroll
    for (int q = 0; q < 8; ++q) tot += wl[136 + q];
    const float fs = 1.0f / ((tot + 1e-6f) * (float)N);
    if (tid == 0) { cf t0 = a[fpad(0)]; t0.x += INP(I_SKIP)[jh * 1024 + c] * (tot + 1e-6f); a[fpad(0)] = t0; }
    __syncthreads();
    fft_pass8<false, N>(a, N, tid, 512); __syncthreads();
    fft_mid<false, LOG_N>(a, N, tid);
    cf kreg[RL];
    { const int pb = fpad((tid % (N >> LOG_LAST)) * RL);
#pragma unroll
      for (int e = 0; e < RL; ++e) kreg[e] = a[pb + e];
      dif_group<LOG_LAST, true, false>(kreg, cf{1.f, 0.f}); }
    __syncthreads();
#pragma unroll 1
    for (int rd = 0; rd < NRND; ++rd) {
        for (int g = tid; g < NTOT / 8; g += 512) {
            const int arr = g / S0, j = g - arr * S0; const int sq = 2 * (rd * NAR + arr);
            const bf16_t* p0 = vbase + (((size_t)sq * 1024 + c) << LOG_L) + j; const bf16_t* p1 = p0 + ((size_t)1024 << LOG_L);
            cf x[8];
#pragma unroll
            for (int m = 0; m < 4; ++m) x[m] = cf{bf2f(p0[m * S0]), bf2f(p1[m * S0])};
#pragma unroll
            for (int m = 4; m < 8; ++m) x[m] = cf{0.f, 0.f};
            dif_group<3, false, true>(x, twid((float)j * (1.0f / (float)N)));
            const int pb = fpad(arr * N + j);
#pragma unroll
            for (int m = 0; m < 8; ++m) a[pb + goff<S0>(m)] = x[m];
        }
        __syncthreads();
        fft_mid<false, LOG_N>(a, NTOT, tid);
        for (int g = tid; g < (NTOT >> LOG_LAST); g += 512) {
            cf x[RL]; const int pb = fpad(g << LOG_LAST);
#pragma unroll
            for (int e = 0; e < RL; ++e) x[e] = a[pb + e];
            dif_group<LOG_LAST, true, false>(x, cf{1.f, 0.f});
#pragma unroll
            for (int e = 0; e < RL; ++e) x[e] = cmul(x[e], kreg[e]);
            dit_group<LOG_LAST, true, false>(x, cf{1.f, 0.f});
#pragma unroll
            for (int e = 0; e < RL; ++e) a[pb + e] = x[e];
        }
        __syncthreads();
        fft_mid<true, LOG_N>(a, NTOT, tid);
        for (int g = tid; g < NTOT / 8; g += 512) {
            const int arr = g / S0, j = g - arr * S0; const int sq = 2 * (rd * NAR + arr);
            bf16_t* p0 = vbase + (((size_t)sq * 1024 + c) << LOG_L) + j; bf16_t* p1 = p0 + ((size_t)1024 << LOG_L);
            cf x[8]; const int pb = fpad(arr * N + j);
#pragma unroll
            for (int m = 0; m < 8; ++m) x[m] = a[pb + goff<S0>(m)];
            dit_group<3, false, true>(x, twid((float)j * (1.0f / (float)N)));
#pragma unroll
            for (int m = 0; m < 4; ++m) { const float y0 = x[m].x * fs, y1 = x[m].y * fs; if (!dry || y0 == 1.2345e30f) { p0[m * S0] = (bf16_t)f2bf(y0); p1[m * S0] = (bf16_t)f2bf(y1); } }
        }
        __syncthreads();
    }
}
__device__ __forceinline__ void phase_fft(int jh, unsigned char* lds, bool dry) {
    for (int it = blockIdx.x; it < 2048; it += gridDim.x) {
        if (it < 1024) hyena_fft_unit<13>(jh, it, lds, dry); else hyena_fft_unit<9>(jh, it - 1024, lds, dry);
    }
}
#define LAS __attribute__((address_space(3)))
#define XB_TMO      128
#define XB_XCNT(j)  (256  + 64 * (j))
#define XB_XSUB(j)  (1280 + 64 * (j))
#define XB_XGEN(j)  (2304 + 64 * (j))
#define XB_TOP      3328
#define XB_TOPGEN   3392
#define XCD_BAR_WORDS 3456
#define XB_SPIN_CAP (1u << 18)

__device__ __forceinline__ unsigned xb_ld(unsigned* p)              { return __hip_atomic_load(p, __ATOMIC_RELAXED, __HIP_MEMORY_SCOPE_AGENT); }
__device__ __forceinline__ unsigned xb_add(unsigned* p, unsigned v) { return __hip_atomic_fetch_add(p, v, __ATOMIC_RELAXED, __HIP_MEMORY_SCOPE_AGENT); }
__device__ __forceinline__ unsigned xb_xcc_id() { return (unsigned)__builtin_amdgcn_s_getreg((3 << 11) | 20) & 0xFu; }
#define XB_SPIN(cond, bar) do { unsigned _sp = 0; while (cond) { __builtin_amdgcn_s_sleep(1); \
    if ((++_sp & 255u) == 0u) { if (xb_ld(&(bar)[XB_TMO])) break; if (_sp > XB_SPIN_CAP) { atomicAdd(&(bar)[XB_TMO], 1u); break; } } } } while (0)

struct XcdBarrier {
    unsigned* bar; unsigned x;
    volatile LAS unsigned* st;
};

__device__ __forceinline__ XcdBarrier xcd_barrier_post(unsigned* bar, volatile LAS unsigned* st) {
    XcdBarrier b; b.bar = bar; b.x = xb_xcc_id(); b.st = st;
    if (threadIdx.x == 0) (void)xb_add(&bar[XB_XCNT(b.x)], 1u);
    return b;
}
__device__ __forceinline__ void xcd_barrier_complete(unsigned* bar, unsigned x, unsigned& nloc, unsigned& nx) {
    const unsigned G = gridDim.x * gridDim.y * gridDim.z;
    unsigned sum, cnt, mine, sp = 0u;
    for (;;) {
        sum = 0u; cnt = 0u; mine = 0u;
#pragma unroll
        for (unsigned j = 0; j < 16; ++j) { const unsigned c = xb_ld(&bar[XB_XCNT(j)]); sum += c; cnt += (c > 0u) ? 1u : 0u; mine = (j == x) ? c : mine; }
        if (sum == G) break;
        __builtin_amdgcn_s_sleep(1);
        if ((++sp & 255u) == 0u) { if (xb_ld(&bar[XB_TMO])) break; if (sp > XB_SPIN_CAP) { atomicAdd(&bar[XB_TMO], 1u); break; } }
    }
    nloc = mine > 0u ? mine : 1u; nx = cnt > 0u ? cnt : 1u;
}

__device__ __forceinline__ void xcd_barrier(const XcdBarrier& b) {
    asm volatile("s_waitcnt vmcnt(0)" ::: "memory");
    __syncthreads();
    if (threadIdx.x == 0) {
        unsigned* bar = b.bar;
        __builtin_amdgcn_s_waitcnt(0);
        unsigned nloc = b.st[0], nx = b.st[1];
        if (nloc == 0u) { xcd_barrier_complete(bar, b.x, nloc, nx); b.st[0] = nloc; b.st[1] = nx; }
        const unsigned old = xb_add(&bar[XB_XSUB(b.x)], 1u);
        const unsigned gen = old / nloc;
        if (old + 1u == (gen + 1u) * nloc) {
            __builtin_amdgcn_fence(__ATOMIC_RELEASE, "agent");
            asm volatile("s_waitcnt vmcnt(0)" ::: "memory");
            const unsigned og = xb_add(&bar[XB_TOP], 1u);
            const unsigned tg = og / nx;
            if (og + 1u == (tg + 1u) * nx) xb_add(&bar[XB_TOPGEN], 1u);
            else XB_SPIN(xb_ld(&bar[XB_TOPGEN]) == tg, bar);
            __builtin_amdgcn_fence(__ATOMIC_ACQUIRE, "agent");
            xb_add(&bar[XB_XGEN(b.x)], 1u);
            asm volatile("s_waitcnt vmcnt(0)" ::: "memory");
        } else {
            XB_SPIN(xb_ld(&bar[XB_XGEN(b.x)]) == gen, bar);
            __builtin_amdgcn_fence(__ATOMIC_ACQUIRE, "agent");
            asm volatile("s_waitcnt vmcnt(0)" ::: "memory");
        }
    }
    __syncthreads();
}
__global__ void __launch_bounds__(512, 2) fwd_megakernel(Params p) {
    extern __shared__ __attribute__((aligned(16))) unsigned char lds[];
    cg::grid_group grid = cg::this_grid();
    const int G = gridDim.x;
    { volatile LAS unsigned* st0 = (volatile LAS unsigned*)((LAS unsigned char*)lds + (LDS_BYTES - 64)); if (tidx() < 2) st0[tidx() & 1] = 0u;
      if (blockIdx.x == 0) { unsigned* bw = (unsigned*)(WSP()); for (int i = tidx(); i < XCD_BAR_WORDS; i += 512) __hip_atomic_store(bw + i, 0u, __ATOMIC_RELAXED, __HIP_MEMORY_SCOPE_AGENT); }
      __syncthreads(); }
#define GSYNC() do { XcdBarrier b_; b_.bar = (unsigned*)(WSP()); b_.x = xb_xcc_id(); b_.st = (volatile LAS unsigned*)((LAS unsigned char*)lds + (LDS_BYTES - 64)); xcd_barrier(b_); } while (0)
#ifndef NO_P0
    phase0(lds);
#ifdef PROBE_P0
    __syncthreads(); phase0(lds); __syncthreads(); phase0(lds);
#endif
#endif
    grid.sync();
    (void)xcd_barrier_post((unsigned*)(WSP()), (volatile LAS unsigned*)((LAS unsigned char*)lds + (LDS_BYTES - 64)));
#pragma unroll 1
    for (int s = 0; s < 8; ++s) {
        const int layer = s >> 1; const bool isffn = s & 1, ishy = layer & 1; const int j = layer >> 1;
        unsigned char* ws = WSP();
        const float* mods_l = (const float*)(ws + WS_MODS) + (size_t)layer * 9 * 6144;
        const bool early = (G == 256) && layer > 0;
        if (!isffn) { phase_convert_weights(layer, lds, early ? 2 : 0, (int)blockIdx.x, G); if (!ishy) phase_cache_convert(j); }
        if (!isffn && ishy && !early) phase_filter(j, lds, (int)blockIdx.x, G);
        phase_norm((isffn ? INP(I_N2G) : INP(I_N1G)) + layer * 1024, mods_l, isffn ? 3 : 0, s == 0);
        GSYNC();
        if (isffn) {
            pg8::Gemm g{(const pg8::bf16_t*)(ws + WS_H), (const pg8::bf16_t*)(ws + WS_WGU), T_ALL, 2 * DFF, 1024}; pg8::StaticOrder S; S.init(T_ALL, 2 * DFF, G, (int)blockIdx.x);
            pg8::EpiSwiglu E{(pg8::bf16_t*)(ws + WS_ACT)};
            #ifndef NO_G1
pg8::gemm_phase<pg8::EpiSwiglu, pg8::StaticOrder, true, true>((PG8_LAS unsigned char*)lds, g, S, E);
#ifdef PROBE_G1
            pg8::gemm_phase<pg8::EpiSwiglu, pg8::StaticOrder, true, true>((PG8_LAS unsigned char*)lds, g, S, E);
#endif
#endif
        } else if (ishy) {
            pg8::Gemm g{(const pg8::bf16_t*)(ws + WS_H), (const pg8::bf16_t*)(ws + WS_W1), T_ALL, 3072, 1024}; pg8::StaticOrder S; S.init(T_ALL, 3072, G, (int)blockIdx.x);
            pg8::EpiBf16 E{(pg8::bf16_t*)(ws + WS_U), 3072, INP(I_HBIN) + (size_t)j * 3072};
            #ifndef NO_G2
pg8::gemm_phase<pg8::EpiBf16, pg8::StaticOrder, true, true>((PG8_LAS unsigned char*)lds, g, S, E);
#ifdef PROBE_G1
            pg8::gemm_phase<pg8::EpiBf16, pg8::StaticOrder, true, true>((PG8_LAS unsigned char*)lds, g, S, E);
#endif
#endif
        } else {
            pg8::Gemm g{(const pg8::bf16_t*)(ws + WS_H), (const pg8::bf16_t*)(ws + WS_W1), T_ALL, 3072, 1024}; pg8::StaticOrder S; S.init(T_ALL, 3072, G, (int)blockIdx.x);
            float* ck = OUTP() + (size_t)T_ALL * 1024 + (size_t)j * 256 * 1024;
            static_assert(WS_K == WS_Q + (72u << 20) && WS_V == WS_Q + (152u << 20), "EpiQKV buffer spacing");
            pg8::EpiQKV E{ws + WS_Q, ck, (const float*)(ws + WS_ROPE), (const float*)(ws + WS_ROPE) + 1024};
            #ifndef NO_G3
pg8::gemm_phase<pg8::EpiQKV, pg8::StaticOrder, true, true>((PG8_LAS unsigned char*)lds, g, S, E);
#ifdef PROBE_G1
            pg8::gemm_phase<pg8::EpiQKV, pg8::StaticOrder, true, true>((PG8_LAS unsigned char*)lds, g, S, E);
#endif
#endif
        }
        GSYNC();
        if (!isffn) {
            if (ishy) { phase_conv3(j, lds); GSYNC();
#ifndef NO_FFT
#ifdef PROBE_FFT
phase_fft(j, lds, true); GSYNC();
#endif
phase_fft(j, lds, false);
#endif
 GSYNC(); phase_gate(j, lds); GSYNC(); }
            else {
#ifndef NO_ATT
phase_attention(lds);
#ifdef PROBE_ATT
 GSYNC(); phase_attention(lds);
#endif
#endif
 GSYNC(); phase_combine(layer); GSYNC(); }
        }
        {
            const pg8::bf16_t* A = isffn ? (const pg8::bf16_t*)(ws + WS_ACT) : (const pg8::bf16_t*)(ws + WS_H);
            const pg8::bf16_t* B = isffn ? (const pg8::bf16_t*)(ws + WS_WDN) : (const pg8::bf16_t*)(ws + WS_W2);
            const int K = isffn ? DFF : 1024;
            pg8::Gemm g{A, B, T_ALL, 1024, K}; pg8::StaticOrder S; S.init(T_ALL, 1024, G, (int)blockIdx.x);
            const float* bias = (!isffn && ishy) ? INP(I_HBOUT) + (size_t)j * 1024 : nullptr;
            pg8::EpiRes E{(pg8::bf16_t*)(ws + WS_X16), INP(I_XP), INP(I_XS), mods_l + (isffn ? 5 : 2) * 1024, bias, s == 0 ? 1 : 0};
            #ifndef NO_G4
pg8::gemm_phase<pg8::EpiRes, pg8::StaticOrder, true, true>((PG8_LAS unsigned char*)lds, g, S, E);
#endif
        }
        if (isffn && layer < 3 && G == 256 && blockIdx.x >= 64) {
            phase_convert_weights(layer + 1, lds, 1, (int)blockIdx.x - 64, 192);
            if ((layer + 1) & 1) phase_filter((layer + 1) >> 1, lds, (int)blockIdx.x - 64, 192);
        }
        GSYNC();
    }
#ifdef PROBE_SYNC
#pragma unroll 1
    for (int q = 0; q < 40; ++q) GSYNC();
#endif
    phase_final_norm();
}

extern "C" void kernel_launch(void* const* d_in, const int* in_sizes, int n_in, void* d_out, int out_size, void* d_ws, size_t ws_size, hipStream_t stream) {
    static int grid_blocks = 0;
    if (grid_blocks == 0) {
        if (n_in != 31 || ws_size < WS_END) { fprintf(stderr, "kernel_launch: unexpected n_in %d or ws_size %zu (need %zu)\n", n_in, ws_size, (size_t)WS_END); grid_blocks = -1; return; }
        int dev = 0, cus = 0, per_cu = 0;
        hipGetDevice(&dev);
        hipDeviceGetAttribute(&cus, hipDeviceAttributeMultiprocessorCount, dev);
        if (hipFuncSetAttribute((const void*)fwd_megakernel, hipFuncAttributeMaxDynamicSharedMemorySize, LDS_BYTES) != hipSuccess) { fprintf(stderr, "kernel_launch: hipFuncSetAttribute failed\n"); grid_blocks = -1; return; }
        if (hipOccupancyMaxActiveBlocksPerMultiprocessor(&per_cu, (const void*)fwd_megakernel, 512, LDS_BYTES) != hipSuccess || per_cu < 1) { fprintf(stderr, "kernel_launch: occupancy query says %d\n", per_cu); per_cu = 1; }
        (void)hipGetLastError();
        grid_blocks = cus * 1;
        fprintf(stderr, "kernel_launch: cus %d per_cu %d grid %d ws %zu\n", cus, per_cu, grid_blocks, ws_size);
    }
    if (grid_blocks < 0) return;
    Params p{};
    for (int i = 0; i < 31; ++i) p.in[i] = (const float*)d_in[i];
    p.out = (float*)d_out; p.ws = (unsigned char*)d_ws;
    void* args[] = {&p};
    hipError_t e = hipLaunchCooperativeKernel((const void*)fwd_megakernel, dim3(grid_blocks), dim3(512), args, LDS_BYTES, stream);
    if (e != hipSuccess) fprintf(stderr, "kernel_launch: cooperative launch failed: %s (grid %d)\n", hipGetErrorString(e), grid_blocks);
}
```
